# Optimizing an MI355X kernel written in HIP

```python
import jax, jax.numpy as jnp
from jax import lax
import numpy as np

D_MODEL = 1024
BATCH = 8
SEQ = 2048
DEPTH = 1
DEC_BATCH = 128
DEC_SEQ = 4
PAST_LEN = 16384
PAGE_SIZE = 128

N_META = 16
CONV_CH = D_MODEL // 2
SCONV_K = 3
GDN_HEADS = 4
GDN_DK = 128
GDN_DV = 128
GDN_CONV_K = 4
CHUNK = 64
FFN_HIDDEN = 4 * D_MODEL
EPS = 1e-6

QKV_W = GDN_HEADS * (2 * GDN_DK + GDN_DV)
O_B = 0
O_C = O_B + CONV_CH
O_H = O_C + CONV_CH
O_QKV = O_H + CONV_CH
O_G = O_QKV + QKV_W
O_A = O_G + GDN_HEADS * GDN_DV
O_BETA = O_A + GDN_HEADS
IN_W = O_BETA + GDN_HEADS
MIX_W = CONV_CH + GDN_HEADS * GDN_DV

kernel_name = 'hymba_shortconv_gated_deltanet_step'


def rmsnorm(x, g):
    xf = x.astype(jnp.float32)
    y = xf * lax.rsqrt(jnp.mean(xf * xf, axis=-1, keepdims=True) + EPS)
    return (y * g.astype(jnp.float32)).astype(x.dtype)


def l2norm(x):
    return x * lax.rsqrt(jnp.sum(x * x, axis=-1, keepdims=True) + EPS)


def causal_dwconv(x, buf, w):
    xp = jnp.concatenate([buf.astype(x.dtype), x], axis=1)
    y = lax.conv_general_dilated(xp, w[:, None, :].astype(x.dtype), window_strides=(1,), padding='VALID',
                                 dimension_numbers=('NWC', 'WIO', 'NWC'), feature_group_count=x.shape[-1])
    return y, xp[:, xp.shape[1] - (w.shape[0] - 1):]


def chunk_len(t):
    return CHUNK if t % CHUNK == 0 else t


def gated_delta_chunked(q, k, v, g, beta, state, chunk):
    b, t, h, _ = q.shape
    dv = v.shape[-1]
    n = t // chunk

    def blocks(a):
        a = a.reshape((b, n, chunk, h) + a.shape[3:])
        return jnp.moveaxis(jnp.moveaxis(a, 1, 0), 2, 3)

    qc, kc, vc, gc, bc = blocks(q), blocks(k), blocks(v), blocks(g), blocks(beta)
    G = jnp.cumsum(gc, axis=-1)
    idx = jnp.arange(chunk)
    causal = idx[:, None] >= idx[None, :]
    strict = idx[:, None] > idx[None, :]
    decay = jnp.exp(jnp.where(causal, G[..., :, None] - G[..., None, :], -jnp.inf))
    kb = kc * bc[..., None]
    lower = jnp.where(strict, jnp.einsum('nbhid,nbhjd->nbhij', kb, kc) * decay, 0.0)
    eye = jnp.eye(chunk, dtype=jnp.float32)
    rhs = jnp.concatenate([vc * bc[..., None], kb * jnp.exp(G)[..., None]], axis=-1)
    sol = lax.linalg.triangular_solve(eye + lower, rhs, left_side=True, lower=True)
    u, w = sol[..., :dv], sol[..., dv:]
    qk = jnp.einsum('nbhid,nbhjd->nbhij', qc, kc) * decay
    q_dec = qc * jnp.exp(G)[..., None]
    g_last = G[..., -1]
    k_dec = kc * jnp.exp(g_last[..., None] - G)[..., None]

    def step(S, xs):
        u_i, w_i, qk_i, qd_i, kd_i, gl_i = xs
        v_new = u_i - jnp.einsum('bhcd,bhde->bhce', w_i, S)
        o_i = jnp.einsum('bhcd,bhde->bhce', qd_i, S) + jnp.einsum('bhij,bhje->bhie', qk_i, v_new)
        S = S * jnp.exp(gl_i)[..., None, None] + jnp.einsum('bhcd,bhce->bhde', kd_i, v_new)
        return S, o_i

    S, o = lax.scan(step, state, (u, w, qk, q_dec, k_dec, g_last))
    o = jnp.moveaxis(jnp.moveaxis(o, 3, 2), 0, 1).reshape(b, t, h, dv)
    return o, S


def hybrid_layer(h, buf_a, buf_qkv, ssm, segments, norm_mix, w_in, conv_a_w, conv_qkv_w, a_log, dt_bias,
                 gdn_norm, w_out, norm_ffn, w_up, w_down):
    f32 = jnp.float32
    bsz, t, _ = h.shape
    xn = rmsnorm(h, norm_mix)
    z = xn @ w_in
    conv_out, new_a = causal_dwconv(z[..., O_C:O_H] * z[..., O_H:O_QKV], buf_a, conv_a_w)
    y_a = z[..., O_B:O_C] * conv_out
    qkv, new_qkv = causal_dwconv(z[..., O_QKV:O_G], buf_qkv, conv_qkv_w)
    qkv = jax.nn.silu(qkv.astype(f32))
    nq = GDN_HEADS * GDN_DK
    q = l2norm(qkv[..., :nq].reshape(bsz, t, GDN_HEADS, GDN_DK)) * (GDN_DK ** -0.5)
    k = l2norm(qkv[..., nq:2 * nq].reshape(bsz, t, GDN_HEADS, GDN_DK))
    v = qkv[..., 2 * nq:].reshape(bsz, t, GDN_HEADS, GDN_DV)
    g = -jnp.exp(a_log.astype(f32)) * jax.nn.softplus(z[..., O_A:O_BETA].astype(f32) + dt_bias.astype(f32))
    beta = jax.nn.sigmoid(z[..., O_BETA:IN_W].astype(f32))
    S = ssm.astype(f32)
    outs = []
    start = 0
    for seg in segments:
        sl = slice(start, start + seg)
        o_s, S = gated_delta_chunked(q[:, sl], k[:, sl], v[:, sl], g[:, sl], beta[:, sl], S, chunk_len(seg))
        outs.append(o_s)
        start += seg
    o = jnp.concatenate(outs, axis=1)
    gate = z[..., O_G:O_A].reshape(bsz, t, GDN_HEADS, GDN_DV).astype(f32)
    o = rmsnorm(o, gdn_norm) * jax.nn.silu(gate)
    y_b = o.reshape(bsz, t, GDN_HEADS * GDN_DV).astype(h.dtype)
    h = h + jnp.concatenate([y_a, y_b], axis=-1) @ w_out
    u = jax.nn.relu(rmsnorm(h, norm_ffn) @ w_up)
    h = h + (u * u) @ w_down
    return h, new_a, new_qkv, S.astype(ssm.dtype)


def setup_inputs(seed: int = 0) -> dict:
    key = jax.random.key(seed)
    ks = jax.random.split(key, 20)
    nrm = jax.random.normal
    f32 = jnp.float32
    x_prompt = nrm(ks[0], (BATCH, SEQ, D_MODEL), f32)
    x_sample = nrm(ks[1], (DEC_BATCH, DEC_SEQ, D_MODEL), f32)
    state_conv_a = nrm(ks[2], (DEPTH, DEC_BATCH, SCONV_K - 1, CONV_CH), f32)
    state_conv_qkv = nrm(ks[3], (DEPTH, DEC_BATCH, GDN_CONV_K - 1, QKV_W), f32)
    state_ssm = 0.3 * nrm(ks[4], (DEPTH, DEC_BATCH, GDN_HEADS, GDN_DK, GDN_DV), f32)
    meta_tokens = nrm(ks[5], (N_META, D_MODEL), f32)
    norm_mix = 1.0 + 0.02 * nrm(ks[6], (DEPTH, D_MODEL), f32)
    w_in = nrm(ks[7], (DEPTH, D_MODEL, IN_W), f32) * D_MODEL ** -0.5
    conv_a_w = nrm(ks[8], (DEPTH, SCONV_K, CONV_CH), f32) * SCONV_K ** -0.5
    conv_qkv_w = nrm(ks[9], (DEPTH, GDN_CONV_K, QKV_W), f32) * GDN_CONV_K ** -0.5
    a_log = jnp.log(jax.random.uniform(ks[10], (DEPTH, GDN_HEADS), f32, 1.0, 16.0))
    dt = jnp.exp(jax.random.uniform(ks[11], (DEPTH, GDN_HEADS), f32, np.log(1e-3), np.log(1e-1)))
    dt_bias = dt + jnp.log(-jnp.expm1(-dt))
    gdn_norm = 1.0 + 0.02 * nrm(ks[12], (DEPTH, GDN_DV), f32)
    w_out = nrm(ks[13], (DEPTH, MIX_W, D_MODEL), f32) * MIX_W ** -0.5
    norm_ffn = 1.0 + 0.02 * nrm(ks[14], (DEPTH, D_MODEL), f32)
    w_up = nrm(ks[15], (DEPTH, D_MODEL, FFN_HIDDEN), f32) * D_MODEL ** -0.5
    w_down = nrm(ks[16], (DEPTH, FFN_HIDDEN, D_MODEL), f32) * FFN_HIDDEN ** -0.5
    norm_final = 1.0 + 0.02 * nrm(ks[17], (D_MODEL,), f32)
    return {'x_prompt': x_prompt, 'x_sample': x_sample, 'state_conv_a': state_conv_a,
            'state_conv_qkv': state_conv_qkv, 'state_ssm': state_ssm, 'meta_tokens': meta_tokens,
            'norm_mix': norm_mix, 'w_in': w_in, 'conv_a_w': conv_a_w, 'conv_qkv_w': conv_qkv_w,
            'a_log': a_log, 'dt_bias': dt_bias, 'gdn_norm': gdn_norm, 'w_out': w_out,
            'norm_ffn': norm_ffn, 'w_up': w_up, 'w_down': w_down, 'norm_final': norm_final}


def reference(x_prompt, x_sample, state_conv_a, state_conv_qkv, state_ssm, meta_tokens, norm_mix, w_in,
              conv_a_w, conv_qkv_w, a_log, dt_bias, gdn_norm, w_out, norm_ffn, w_up, w_down, norm_final):
    bp, tp, _ = x_prompt.shape
    bs, ts, _ = x_sample.shape
    meta = jnp.broadcast_to(meta_tokens[None].astype(x_prompt.dtype), (bp, N_META, D_MODEL))
    hp = jnp.concatenate([meta, x_prompt], axis=1)
    hs = x_sample
    pa, pq, ps, sa, sq, ss = [], [], [], [], [], []
    for l in range(DEPTH):
        lw = (norm_mix[l], w_in[l], conv_a_w[l], conv_qkv_w[l], a_log[l], dt_bias[l], gdn_norm[l],
              w_out[l], norm_ffn[l], w_up[l], w_down[l])
        hp, a_p, q_p, s_p = hybrid_layer(
            hp, jnp.zeros((bp, SCONV_K - 1, CONV_CH), x_prompt.dtype),
            jnp.zeros((bp, GDN_CONV_K - 1, QKV_W), x_prompt.dtype),
            jnp.zeros((bp, GDN_HEADS, GDN_DK, GDN_DV), state_ssm.dtype), (N_META, tp), *lw)
        hs, a_s, q_s, s_s = hybrid_layer(hs, state_conv_a[l], state_conv_qkv[l], state_ssm[l], (ts,), *lw)
        pa.append(a_p); pq.append(q_p); ps.append(s_p)
        sa.append(a_s.astype(state_conv_a.dtype)); sq.append(q_s.astype(state_conv_qkv.dtype)); ss.append(s_s)
    y_prompt = rmsnorm(hp, norm_final)[:, N_META:]
    y_sample = rmsnorm(hs, norm_final)
    return (y_prompt, y_sample, jnp.stack(pa), jnp.stack(pq), jnp.stack(ps), jnp.stack(sa), jnp.stack(sq), jnp.stack(ss))
```

```cpp
#include <hip/hip_runtime.h>
#include <hip/hip_cooperative_groups.h>
#include <cstdio>
#include <cstdint>
namespace cg = cooperative_groups;
namespace pg8 {
#define PG8_LAS __attribute__((address_space(3)))
typedef unsigned short bf16_t;
typedef short bf16x8 __attribute__((ext_vector_type(8)));
typedef float f32x4 __attribute__((ext_vector_type(4)));
typedef unsigned u32x4 __attribute__((ext_vector_type(4)));
constexpr int BM = 256, BK = 64, HALF = 128, HTB = HALF * BK * 2  , STAGE_BYTES = 8 * HTB, NXCD = 8, WGM = 8;

__host__ __device__ __forceinline__ int lds_byte(int r, int c) { const int st = (r >> 4) * 2 + (c >> 5), rr = r & 15, cc = c & 31, ob = rr * 64 + cc * 2; return st * 1024 + (ob ^ (((ob >> 9) & 1) << 5)); }
__host__ __device__ __forceinline__ void stage_rc(int b, int& R, int& C) { const int st = b / 1024, sb = b % 1024, swz = sb ^ (((sb >> 9) & 1) << 5); R = (st >> 1) * 16 + swz / 64; C = (st & 1) * 32 + (swz % 64) / 2; }
__host__ __device__ __forceinline__ int perm32(int rho) { const int n = rho >> 4, i = rho & 15; return 8 * (i >> 2) + 4 * n + (i & 3); }

struct Unit { int pm, pn, k0, nt; };
struct Gemm { const bf16_t* A; const bf16_t* Bt; int M, N, K; };

struct StaticOrder {
    int nM, nN, nwg, G, c, ntk;
    __host__ __device__ void init(int M, int N, int G_, int c_, int K_) { nM = M / BM; nN = N / BM; nwg = nM * nN; G = G_; c = c_; ntk = K_ / BK; }
    __host__ __device__ __forceinline__ bool next(int i, Unit& u) const {
        const long L = (long)i * G + c; if (L >= nwg) return false;
        int wgid = (int)L; { const int q = nwg / NXCD, r = nwg % NXCD, xcd = wgid % NXCD, off = wgid / NXCD; wgid = (xcd < r ? xcd * (q + 1) : r * (q + 1) + (xcd - r) * q) + off; }
        const int nig = WGM * nN, gid = wgid / nig, fm = gid * WGM, gsz = (nM - fm) < WGM ? (nM - fm) : WGM;
        u.pm = fm + ((wgid % nig) % gsz); u.pn = (wgid % nig) / gsz; u.k0 = 0; u.nt = ntk; return true;
    }
    __device__ __forceinline__ void a_ready(const Unit&) const {}
    __device__ __forceinline__ void done(const Unit&) const {}
};
struct SplitTailOrder {
    StaticOrder base; int nfull, nN, nks, ntail, G, c, ntk, tail_first, coff; const unsigned* ready; unsigned need;
    __host__ __device__ void init(int Mfull, int Mtail, int N, int G_, int c_, int K_, int nks_, int coff_ = 0, const unsigned* ready_ = nullptr, unsigned need_ = 0u) { base.init(Mfull, N, G_, c_, K_); nfull = base.nwg; nN = N / BM; nks = nks_; ntail = (Mtail / BM) * nN * nks_; G = G_; c = c_; ntk = K_ / BK; tail_first = 0; coff = coff_; ready = ready_; need = need_; }
    __host__ __device__ __forceinline__ bool next(int i, Unit& u) const {
        long L = (long)i * G + c;
        if (tail_first) { const bool has_tail = c < ntail; if (i > (has_tail ? 1 : 0)) return false; L = (has_tail && i == 0) ? (long)nfull + c : (long)c; }
        int pm_, pn_, k0_, nt_;
        if (L < nfull) {
            int wgid = (int)L; { const int q = nfull / NXCD, r = nfull % NXCD, xcd = wgid % NXCD, off = wgid / NXCD; wgid = (xcd < r ? xcd * (q + 1) : r * (q + 1) + (xcd - r) * q) + off; }
            const int nig = WGM * nN, gid = wgid / nig, fm = gid * WGM, gsz = (base.nM - fm) < WGM ? (base.nM - fm) : WGM;
            pm_ = fm + ((wgid % nig) % gsz); pn_ = (wgid % nig) / gsz; k0_ = 0; nt_ = ntk;
        } else {
            const int m = (int)(L - nfull) - coff; if (m < 0 || m >= ntail) return false;
            const int ks = m % nks; pn_ = (m / nks) % nN; pm_ = base.nM + m / (nks * nN); nt_ = ntk / nks; k0_ = ks * nt_ * BK;
        }
        u.pm = pm_; u.pn = pn_; u.k0 = k0_; u.nt = nt_; return true;
    }
    __device__ __forceinline__ void a_ready(const Unit& u) const {
        if (ready && u.pm >= base.nM) {
            if (threadIdx.x < 64) { unsigned polls = 0;
                while ((unsigned)__builtin_amdgcn_readfirstlane(__hip_atomic_load(ready + 16 * u.pm, __ATOMIC_RELAXED, __HIP_MEMORY_SCOPE_AGENT)) < need) { __builtin_amdgcn_s_sleep(2); if (++polls > (1u << 22)) break; }
                __builtin_amdgcn_fence(__ATOMIC_ACQUIRE, "agent");
                asm volatile("s_waitcnt vmcnt(0)" ::: "memory"); }
            asm volatile("" ::: "memory"); __builtin_amdgcn_s_barrier(); asm volatile("" ::: "memory");
        }
    }
    __device__ __forceinline__ void done(const Unit&) const {}
};
struct OneUnitOrder {
    int pm, pn, ntk;
    __host__ __device__ __forceinline__ bool next(int i, Unit& u) const { if (i != 0) return false; u.pm = pm; u.pn = pn; u.k0 = 0; u.nt = ntk; return true; }
    __device__ __forceinline__ void a_ready(const Unit&) const {}
    __device__ __forceinline__ void done(const Unit&) const {}
};

typedef unsigned u32x2 __attribute__((ext_vector_type(2)));
typedef float cvt_f32x2 __attribute__((ext_vector_type(2)));
typedef __bf16 cvt_bf16x2 __attribute__((ext_vector_type(2)));
__device__ __forceinline__ unsigned cvt_pk_bf16(float lo, float hi) { const cvt_f32x2 v = {lo, hi}; const cvt_bf16x2 b = __builtin_convertvector(v, cvt_bf16x2); return __builtin_bit_cast(unsigned, b); }
struct EpiZ {
    static constexpr bool PERM = true, AFTER_DRAIN = false;
    bf16_t* O; int ldc; const float* rs;
    __device__ __forceinline__ void operator()(const f32x4 (&acc)[2][2][4][2], const Unit& u, int wr, int wc, int fr, int fq) const {
        const int row0 = u.pm * BM + wr * 64 + fr, col0 = u.pn * BM + wc * 32 + 8 * fq;
        float sv[2][4];
#pragma unroll
        for (int ai = 0; ai < 2; ++ai)
#pragma unroll
            for (int m = 0; m < 4; ++m) sv[ai][m] = rs[row0 + ai * HALF + m * 16];
#pragma unroll
        for (int ai = 0; ai < 2; ++ai)
#pragma unroll
            for (int m = 0; m < 4; ++m) { const int row = row0 + ai * HALF + m * 16; const float s = sv[ai][m]; bf16_t* rowp = O + (size_t)row * ldc + col0;
#pragma unroll
                for (int bj = 0; bj < 2; ++bj) { const f32x4 v0 = acc[ai][bj][m][0] * s, v1 = acc[ai][bj][m][1] * s;
                    u32x4 w; w.x = cvt_pk_bf16(v0[0], v0[1]); w.y = cvt_pk_bf16(v0[2], v0[3]); w.z = cvt_pk_bf16(v1[0], v1[1]); w.w = cvt_pk_bf16(v1[2], v1[3]);
                    *(u32x4*)(rowp + bj * HALF) = w; } }
    }
};
struct EpiUp {
    static constexpr bool PERM = true, AFTER_DRAIN = false;
    bf16_t* O; int ldc; const float* ssp;
    __device__ __forceinline__ void operator()(const f32x4 (&acc)[2][2][4][2], const Unit& u, int wr, int wc, int fr, int fq) const {
        const int row0 = u.pm * BM + wr * 64 + fr, col0 = u.pn * BM + wc * 32 + 8 * fq;
        f32x4 sp[2][4];
#pragma unroll
        for (int ai = 0; ai < 2; ++ai)
#pragma unroll
            for (int m = 0; m < 4; ++m) sp[ai][m] = *(const f32x4*)(ssp + (size_t)(row0 + ai * HALF + m * 16) * 16 + 4 * fq);
#pragma unroll
        for (int ai = 0; ai < 2; ++ai)
#pragma unroll
            for (int m = 0; m < 4; ++m) { const int row = row0 + ai * HALF + m * 16; const f32x4 t = sp[ai][m];
                float tt = (t[0] + t[1]) + (t[2] + t[3]); tt += __shfl_xor(tt, 16); tt += __shfl_xor(tt, 32);
                const float s = 1.0f / sqrtf(tt * (1.0f / 1024.0f) + 1e-6f);
                bf16_t* rowp = O + (size_t)row * ldc + col0;
#pragma unroll
                for (int bj = 0; bj < 2; ++bj) { f32x4 v0 = acc[ai][bj][m][0] * s, v1 = acc[ai][bj][m][1] * s;
#pragma unroll
                    for (int j = 0; j < 4; ++j) { v0[j] = v0[j] > 0.f ? v0[j] * v0[j] : 0.f; v1[j] = v1[j] > 0.f ? v1[j] * v1[j] : 0.f; }
                    u32x4 w; w.x = cvt_pk_bf16(v0[0], v0[1]); w.y = cvt_pk_bf16(v0[2], v0[3]); w.z = cvt_pk_bf16(v1[0], v1[1]); w.w = cvt_pk_bf16(v1[2], v1[3]);
                    *(u32x4*)(rowp + bj * HALF) = w; } }
    }
};
template <bool PUB> struct EpiOut {
    static constexpr bool PERM = false, AFTER_DRAIN = false;
    const float* xp; const float* xs; float* out; bf16_t* a2; const float* gf; float* ssp; unsigned* cnt;
    __device__ __forceinline__ void operator()(const f32x4 (&acc)[2][2][4][2], const Unit& u, int wr, int wc, int fr, int fq) const {
        const int row0 = u.pm * BM + wr * 64 + fr, col0 = u.pn * BM + wc * 32 + 4 * fq;
        f32x4 gv[2][2];
#pragma unroll
        for (int bj = 0; bj < 2; ++bj)
#pragma unroll
            for (int n = 0; n < 2; ++n) gv[bj][n] = *(const f32x4*)(gf + col0 + bj * HALF + n * 16);
#pragma unroll
        for (int ai = 0; ai < 2; ++ai) {
            f32x4 hv[4][2][2];
#pragma unroll
            for (int m = 0; m < 4; ++m) { const int row = row0 + ai * HALF + m * 16;
                const float* hin = (row < 16384 ? xp + (size_t)row * 1024 : xs + (size_t)(row - 16384) * 1024) + col0;
#pragma unroll
                for (int bj = 0; bj < 2; ++bj)
#pragma unroll
                    for (int n = 0; n < 2; ++n) hv[m][bj][n] = *(const f32x4*)(hin + bj * HALF + n * 16); }
#pragma unroll
            for (int m = 0; m < 4; ++m) { const int row = row0 + ai * HALF + m * 16;
                float* op = out + (size_t)row * 1024 + col0; bf16_t* ap = a2 + (size_t)row * 1024 + col0; float ss = 0.f;
#pragma unroll
                for (int bj = 0; bj < 2; ++bj)
#pragma unroll
                    for (int n = 0; n < 2; ++n) { const f32x4 h = hv[m][bj][n] + acc[ai][bj][m][n];
                        ss += (h[0] * h[0] + h[1] * h[1]) + (h[2] * h[2] + h[3] * h[3]);
                        const f32x4 av = h * gv[bj][n]; u32x2 w; w.x = cvt_pk_bf16(av[0], av[1]); w.y = cvt_pk_bf16(av[2], av[3]);
                        if (PUB) __hip_atomic_store((unsigned long long*)(ap + bj * HALF + n * 16), (unsigned long long)w.x | ((unsigned long long)w.y << 32), __ATOMIC_RELAXED, __HIP_MEMORY_SCOPE_AGENT); else *(u32x2*)(ap + bj * HALF + n * 16) = w; }
                ss += __shfl_xor(ss, 16); ss += __shfl_xor(ss, 32);
                if (fq == 0) { if (PUB) __hip_atomic_store(ssp + (size_t)row * 16 + u.pn * 4 + wc, ss, __ATOMIC_RELAXED, __HIP_MEMORY_SCOPE_AGENT); else ssp[(size_t)row * 16 + u.pn * 4 + wc] = ss; } }
            asm volatile("" ::: "memory"); }
        if (PUB) { asm volatile("s_waitcnt vmcnt(0)" ::: "memory"); if (fr == 0 && fq == 0) __hip_atomic_fetch_add(cnt + 16 * u.pm, 1u, __ATOMIC_RELAXED, __HIP_MEMORY_SCOPE_AGENT); }
    }
};
struct EpiAcc {
    static constexpr bool PERM = false, AFTER_DRAIN = false;
    float* out; float* part; int ntfull, row_tail, tail_rows, dry; const bf16_t* a2; const float* gf;
    __device__ __forceinline__ void operator()(const f32x4 (&acc)[2][2][4][2], const Unit& u, int wr, int wc, int fr, int fq) const {
        const int row0 = u.pm * BM + wr * 64 + fr, col0 = u.pn * BM + wc * 32 + 4 * fq;
        if (dry) { if (acc[0][0][0][0][0] == 1.2345e30f) out[0] = 0.f; }
        else if (u.nt == ntfull) {
            f32x4 rg[2][2];
#pragma unroll
            for (int bj = 0; bj < 2; ++bj)
#pragma unroll
                for (int n = 0; n < 2; ++n) { const f32x4 g = *(const f32x4*)(gf + col0 + bj * HALF + n * 16); rg[bj][n] = (f32x4){__builtin_amdgcn_rcpf(g[0]), __builtin_amdgcn_rcpf(g[1]), __builtin_amdgcn_rcpf(g[2]), __builtin_amdgcn_rcpf(g[3])}; }
#pragma unroll
            for (int ai = 0; ai < 2; ++ai) {
                u32x2 hv[4][2][2];
#pragma unroll
                for (int m = 0; m < 4; ++m) { const bf16_t* ap = a2 + (size_t)(row0 + ai * HALF + m * 16) * 1024 + col0;
#pragma unroll
                    for (int bj = 0; bj < 2; ++bj)
#pragma unroll
                        for (int n = 0; n < 2; ++n) hv[m][bj][n] = *(const u32x2*)(ap + bj * HALF + n * 16); }
#pragma unroll
                for (int m = 0; m < 4; ++m) { float* op = out + (size_t)(row0 + ai * HALF + m * 16) * 1024 + col0;
#pragma unroll
                    for (int bj = 0; bj < 2; ++bj)
#pragma unroll
                        for (int n = 0; n < 2; ++n) { const u32x2 w = hv[m][bj][n];
                            const f32x4 h2 = (f32x4){__builtin_bit_cast(float, w.x << 16), __builtin_bit_cast(float, w.x & 0xffff0000u), __builtin_bit_cast(float, w.y << 16), __builtin_bit_cast(float, w.y & 0xffff0000u)} * rg[bj][n];
                            *(f32x4*)(op + bj * HALF + n * 16) = h2 + acc[ai][bj][m][n]; } }
                asm volatile("" ::: "memory"); }
        } else {
            float* pb = part + (size_t)(u.k0 / (u.nt * BK)) * tail_rows * 1024;
#pragma unroll
            for (int ai = 0; ai < 2; ++ai)
#pragma unroll
                for (int m = 0; m < 4; ++m) { float* op = pb + (size_t)(row0 + ai * HALF + m * 16 - row_tail) * 1024 + col0;
#pragma unroll
                    for (int bj = 0; bj < 2; ++bj)
#pragma unroll
                        for (int n = 0; n < 2; ++n) *(f32x4*)(op + bj * HALF + n * 16) = acc[ai][bj][m][n]; }
        }
    }
};

struct EpiDownNorm {
    static constexpr bool PERM = false, AFTER_DRAIN = true;
    float* out; float* part; int row_tail, tail_rows; const bf16_t* a2; const float* gf; const float* gfin; float* xch; unsigned* cnt; unsigned* cnt_tail;
    __device__ __forceinline__ void operator()(const f32x4 (&acc)[2][2][4][2], const Unit& u, int wr, int wc, int fr, int fq) const {
        const int row0 = u.pm * BM + wr * 64 + fr, col0 = u.pn * BM + wc * 32 + 4 * fq;
        const __amdgpu_buffer_rsrc_t rs_p = __builtin_amdgcn_make_buffer_rsrc(part, 0, 0x7ffffff0, 0x00020000);
        const unsigned pbo = (unsigned)(u.k0 / (u.nt * BK)) * (unsigned)tail_rows * 4096u;
#pragma unroll
        for (int ai = 0; ai < 2; ++ai)
#pragma unroll
            for (int m = 0; m < 4; ++m) { const unsigned ro = pbo + ((unsigned)(row0 + ai * HALF + m * 16 - row_tail) * 1024u + (unsigned)col0) * 4u;
#pragma unroll
                for (int bj = 0; bj < 2; ++bj)
#pragma unroll
                    for (int n = 0; n < 2; ++n) __builtin_amdgcn_raw_buffer_store_b128(__builtin_bit_cast(u32x4, acc[ai][bj][m][n]), rs_p, ro + (unsigned)(bj * HALF + n * 16) * 4u, 0, 16); }
        asm volatile("s_waitcnt vmcnt(0)" ::: "memory");
        if (fr == 0 && fq == 0) __hip_atomic_fetch_add(cnt_tail, 1u, __ATOMIC_RELAXED, __HIP_MEMORY_SCOPE_AGENT);
    }
    __device__ __forceinline__ void fused(f32x4 (&acc)[2][2][4][2], const Unit& u, int wr, int wc, int fr, int fq, PG8_LAS unsigned char* lds, int wid, int lane) const {
        PG8_LAS float* P = (PG8_LAS float*)lds;
        PG8_LAS float* S = (PG8_LAS float*)(lds + 4096);
        const int row0 = u.pm * BM + wr * 64 + fr, col0 = u.pn * BM + wc * 32 + 4 * fq;
        f32x4 rg[2][2], gq[2][2];
#pragma unroll
        for (int bj = 0; bj < 2; ++bj)
#pragma unroll
            for (int n = 0; n < 2; ++n) { const f32x4 g = *(const f32x4*)(gf + col0 + bj * HALF + n * 16); rg[bj][n] = (f32x4){__builtin_amdgcn_rcpf(g[0]), __builtin_amdgcn_rcpf(g[1]), __builtin_amdgcn_rcpf(g[2]), __builtin_amdgcn_rcpf(g[3])};
                gq[bj][n] = *(const f32x4*)(gfin + col0 + bj * HALF + n * 16); }
#pragma unroll
        for (int ai = 0; ai < 2; ++ai) {
            u32x2 hv[4][2][2];
#pragma unroll
            for (int m = 0; m < 4; ++m) { const bf16_t* ap = a2 + (size_t)(row0 + ai * HALF + m * 16) * 1024 + col0;
#pragma unroll
                for (int bj = 0; bj < 2; ++bj)
#pragma unroll
                    for (int n = 0; n < 2; ++n) hv[m][bj][n] = *(const u32x2*)(ap + bj * HALF + n * 16); }
#pragma unroll
            for (int m = 0; m < 4; ++m) { float ss = 0.f;
#pragma unroll
                for (int bj = 0; bj < 2; ++bj)
#pragma unroll
                    for (int n = 0; n < 2; ++n) { const u32x2 w = hv[m][bj][n];
                        const f32x4 h2 = (f32x4){__builtin_bit_cast(float, w.x << 16), __builtin_bit_cast(float, w.x & 0xffff0000u), __builtin_bit_cast(float, w.y << 16), __builtin_bit_cast(float, w.y & 0xffff0000u)} * rg[bj][n];
                        const f32x4 h3 = h2 + acc[ai][bj][m][n]; acc[ai][bj][m][n] = h3; ss += (h3[0] * h3[0] + h3[1] * h3[1]) + (h3[2] * h3[2] + h3[3] * h3[3]); }
                ss += __shfl_xor(ss, 16); ss += __shfl_xor(ss, 32);
                if (fq == 0) P[(ai * HALF + wr * 64 + m * 16 + fr) * 4 + wc] = ss; }
            asm volatile("" ::: "memory"); }
        asm volatile("s_waitcnt lgkmcnt(0)" ::: "memory"); __builtin_amdgcn_s_barrier(); asm volatile("" ::: "memory");
        const int row = wid * 32 + (lane & 31);
        if (lane < 32) { const f32x4 p4 = *(const PG8_LAS f32x4*)(P + row * 4);
            __hip_atomic_store(xch + ((size_t)(u.pm * BM + row) * 4 + u.pn), (p4[0] + p4[1]) + (p4[2] + p4[3]), __ATOMIC_RELAXED, __HIP_MEMORY_SCOPE_AGENT); }
        asm volatile("s_waitcnt vmcnt(0)" ::: "memory");
        if (lane == 0) __hip_atomic_fetch_add(cnt + 16 * u.pm, 1u, __ATOMIC_RELAXED, __HIP_MEMORY_SCOPE_AGENT);
        if (wid == 0) { unsigned polls = 0;
            while ((unsigned)__builtin_amdgcn_readfirstlane(__hip_atomic_load(cnt + 16 * u.pm, __ATOMIC_RELAXED, __HIP_MEMORY_SCOPE_AGENT)) < 32u) { __builtin_amdgcn_s_sleep(2); if (++polls > (1u << 22)) break; }
            __builtin_amdgcn_fence(__ATOMIC_ACQUIRE, "agent"); }
        asm volatile("s_waitcnt vmcnt(0) lgkmcnt(0)" ::: "memory"); __builtin_amdgcn_s_barrier(); asm volatile("" ::: "memory");
        if (lane < 32) { const float* xp4 = xch + (size_t)(u.pm * BM + row) * 4; float t = 0.f;
#pragma unroll
            for (int q = 0; q < 4; ++q) t += __hip_atomic_load(xp4 + q, __ATOMIC_RELAXED, __HIP_MEMORY_SCOPE_AGENT);
            S[row] = 1.0f / sqrtf(t * (1.0f / 1024.0f) + 1e-6f); }
        asm volatile("s_waitcnt lgkmcnt(0)" ::: "memory"); __builtin_amdgcn_s_barrier(); asm volatile("" ::: "memory");
#pragma unroll
        for (int ai = 0; ai < 2; ++ai)
#pragma unroll
            for (int m = 0; m < 4; ++m) { const int r = ai * HALF + wr * 64 + m * 16 + fr; const float sr = S[r]; float* op = out + (size_t)(u.pm * BM + r) * 1024 + col0;
#pragma unroll
                for (int bj = 0; bj < 2; ++bj)
#pragma unroll
                    for (int n = 0; n < 2; ++n) *(f32x4*)(op + bj * HALF + n * 16) = acc[ai][bj][m][n] * sr * gq[bj][n]; }
    }
};
template <class Epi, class Sched, bool ALIGN_EPI = false, bool SP2 = false>
__device__ __forceinline__ void gemm_phase(PG8_LAS unsigned char* lds, const Gemm g, const Sched& S, const Epi& E) {
    const int tid = threadIdx.x, wid = __builtin_amdgcn_readfirstlane(tid >> 6), lane = tid & 63, wr = wid >> 2, wc = wid & 3, fr = lane & 15, fq = lane >> 4;
    const int K = g.K;
    unsigned voffA[2], voffB[2];
#pragma unroll
    for (int i = 0; i < 2; ++i) { int R, C; stage_rc(tid * 16 + i * 8192, R, C); const int Rb = Epi::PERM ? ((R & ~31) + perm32(R & 31)) : R;
        voffA[i] = (unsigned)(R * K + C) * 2u; voffB[i] = (unsigned)(Rb * K + C) * 2u; }
    const size_t kstep = (size_t)(BK * 2);
    const size_t hstep = (size_t)HALF * K * 2;
    const size_t tstep = 2 * hstep;
    const unsigned ldsw = (unsigned)wid * 1024u;
    const int aoff = lds_byte(wr * 64 + fr, fq * 8), boff = lds_byte(wc * 32 + fr, fq * 8);
#define PG8_SA(b, h) (((b) * 2 + (h)) * HTB)
#define PG8_SB(b, h) ((4 + (b) * 2 + (h)) * HTB)
#define PG8_STAGE(bufoff, gbase, voff) do { _Pragma("unroll") for (int _i = 0; _i < 2; ++_i) \
        __builtin_amdgcn_global_load_lds((const unsigned*)((const char*)(gbase) + (voff)[_i]), (PG8_LAS unsigned*)(lds + (bufoff) + ldsw + _i * 8192), 16, 0, 0); } while (0)
#define PG8_LDA(dst, b, h) do { _Pragma("unroll") for (int m = 0; m < 4; ++m) _Pragma("unroll") for (int k = 0; k < 2; ++k) dst[m][k] = *(const PG8_LAS bf16x8*)(lds + PG8_SA(b, h) + aoff + m * 2048 + k * 1024); } while (0)
#define PG8_LDB(dst, b, h) do { _Pragma("unroll") for (int n = 0; n < 2; ++n) _Pragma("unroll") for (int k = 0; k < 2; ++k) dst[n][k] = *(const PG8_LAS bf16x8*)(lds + PG8_SB(b, h) + boff + n * 2048 + k * 1024); } while (0)
#define PG8_MMA(ai, bj, At, Bt) do { __builtin_amdgcn_s_setprio(1); _Pragma("unroll") for (int m = 0; m < 4; ++m) _Pragma("unroll") for (int n = 0; n < 2; ++n) _Pragma("unroll") for (int k = 0; k < 2; ++k) \
        acc[ai][bj][m][n] = __builtin_amdgcn_mfma_f32_16x16x32_bf16(Bt[n][k], At[m][k], acc[ai][bj][m][n], 0, 0, 0); __builtin_amdgcn_s_setprio(0); } while (0)
#define PG8_WAIT_V(n) asm volatile("s_waitcnt vmcnt(" #n ")" ::: "memory")
#define PG8_WAIT_L(n) asm volatile("s_waitcnt lgkmcnt(" #n ")" ::: "memory")
#define PG8_BAR __builtin_amdgcn_s_barrier()
#define PG8_SCHED __builtin_amdgcn_sched_barrier(0)
    Unit cur, nxt; int ui = 0;
    if (!S.next(0, cur)) return;
    f32x4 acc[2][2][4][2];
#pragma unroll
    for (int a = 0; a < 2; ++a)
#pragma unroll
        for (int b = 0; b < 2; ++b)
#pragma unroll
            for (int m = 0; m < 4; ++m)
#pragma unroll
                for (int n = 0; n < 2; ++n) acc[a][b][m][n] = (f32x4){0.f, 0.f, 0.f, 0.f};
    bf16x8 At[4][2], B0[2][2], B1[2][2];
    const char* cA = (const char*)g.A + (size_t)cur.pm * tstep + (size_t)cur.k0 * 2; const char* cB = (const char*)g.Bt + (size_t)cur.pn * tstep + (size_t)cur.k0 * 2;
    S.a_ready(cur);
    if constexpr (SP2) {
        PG8_STAGE(PG8_SB(0, 0), cB, voffB); PG8_STAGE(PG8_SB(0, 1), cB + hstep, voffB); PG8_STAGE(PG8_SA(0, 0), cA, voffA); PG8_STAGE(PG8_SA(0, 1), cA + hstep, voffA);
        if (wr == 1) PG8_BAR;
        PG8_WAIT_V(2); PG8_BAR;
        PG8_STAGE(PG8_SB(1, 0), cB + kstep, voffB); PG8_STAGE(PG8_SA(1, 0), cA + kstep, voffA); PG8_STAGE(PG8_SB(1, 1), cB + hstep + kstep, voffB);
        PG8_WAIT_V(6); PG8_BAR;
    } else {
        PG8_STAGE(PG8_SB(0, 0), cB, voffB); PG8_STAGE(PG8_SA(0, 0), cA, voffA); PG8_STAGE(PG8_SB(0, 1), cB + hstep, voffB); PG8_STAGE(PG8_SA(0, 1), cA + hstep, voffA);
        if (wr == 1) PG8_BAR;
        PG8_WAIT_V(4); PG8_BAR;
        PG8_STAGE(PG8_SB(1, 0), cB + kstep, voffB); PG8_STAGE(PG8_SA(1, 0), cA + kstep, voffA); PG8_STAGE(PG8_SB(1, 1), cB + hstep + kstep, voffB);
        PG8_WAIT_V(6); PG8_BAR;
    }
    for (;;) {
        const bool has_next = S.next(ui + 1, nxt);
        const char* nA = has_next ? (const char*)g.A + (size_t)nxt.pm * tstep + (size_t)nxt.k0 * 2 : cA; const char* nB = has_next ? (const char*)g.Bt + (size_t)nxt.pn * tstep + (size_t)nxt.k0 * 2 : cB;
        const int nt = cur.nt;
        for (int t = 0; t < nt; t += 2) {
            const bool last = (t == nt - 2);
            const char* a1 = cA + (size_t)(t + 1) * kstep;
            const char* a2 = last ? nA : cA + (size_t)(t + 2) * kstep; const char* b2 = last ? nB : cB + (size_t)(t + 2) * kstep;
            const char* a3 = a2 + kstep; const char* b3 = b2 + kstep;
            if (last && has_next) S.a_ready(nxt);
            if constexpr (SP2) {
            PG8_LDB(B0, 0, 0); PG8_LDB(B1, 0, 1); PG8_SCHED; PG8_LDA(At, 0, 0); PG8_STAGE(PG8_SA(1, 1), a1 + hstep, voffA);
            PG8_WAIT_V(8); PG8_WAIT_L(0); PG8_BAR; PG8_MMA(0, 0, At, B0); PG8_MMA(0, 1, At, B1); PG8_BAR; PG8_SCHED;
            PG8_LDA(At, 0, 1); PG8_STAGE(PG8_SB(0, 0), b2, voffB); PG8_STAGE(PG8_SB(0, 1), b2 + hstep, voffB); PG8_STAGE(PG8_SA(0, 0), a2, voffA);
            PG8_WAIT_V(8); PG8_WAIT_L(0); PG8_BAR; PG8_MMA(1, 0, At, B0); PG8_MMA(1, 1, At, B1); PG8_BAR; PG8_SCHED;
            PG8_LDB(B0, 1, 0); PG8_LDB(B1, 1, 1); PG8_SCHED; PG8_LDA(At, 1, 0); PG8_STAGE(PG8_SA(0, 1), a2 + hstep, voffA);
            PG8_WAIT_V(8); PG8_WAIT_L(0); PG8_BAR; PG8_MMA(0, 0, At, B0); PG8_MMA(0, 1, At, B1); PG8_BAR; PG8_SCHED;
            PG8_LDA(At, 1, 1); PG8_STAGE(PG8_SB(1, 0), b3, voffB); PG8_STAGE(PG8_SB(1, 1), b3 + hstep, voffB); PG8_STAGE(PG8_SA(1, 0), a3, voffA);
            PG8_WAIT_V(8); PG8_WAIT_L(0); PG8_BAR; PG8_MMA(1, 0, At, B0); PG8_MMA(1, 1, At, B1); PG8_BAR; PG8_SCHED;
            } else {
            PG8_LDB(B0, 0, 0); PG8_SCHED; PG8_LDA(At, 0, 0); PG8_STAGE(PG8_SA(1, 1), a1 + hstep, voffA);
            PG8_WAIT_L(8); PG8_BAR; PG8_WAIT_L(0); PG8_MMA(0, 0, At, B0); PG8_BAR; PG8_SCHED;
            PG8_LDB(B1, 0, 1); PG8_STAGE(PG8_SB(0, 0), b2, voffB);
            PG8_BAR; PG8_WAIT_L(0); PG8_MMA(0, 1, At, B1); PG8_BAR;
            PG8_LDA(At, 0, 1); PG8_STAGE(PG8_SA(0, 0), a2, voffA);
            PG8_BAR; PG8_WAIT_L(0); PG8_MMA(1, 0, At, B0); PG8_BAR; PG8_SCHED;
            PG8_STAGE(PG8_SB(0, 1), b2 + hstep, voffB);
            PG8_WAIT_V(6); PG8_BAR; PG8_MMA(1, 1, At, B1); PG8_BAR;
            PG8_LDB(B0, 1, 0); PG8_SCHED; PG8_LDA(At, 1, 0); PG8_STAGE(PG8_SA(0, 1), a2 + hstep, voffA);
            PG8_WAIT_L(8); PG8_BAR; PG8_WAIT_L(0); PG8_MMA(0, 0, At, B0); PG8_BAR; PG8_SCHED;
            PG8_LDB(B1, 1, 1); PG8_STAGE(PG8_SB(1, 0), b3, voffB);
            PG8_BAR; PG8_WAIT_L(0); PG8_MMA(0, 1, At, B1); PG8_BAR;
            PG8_LDA(At, 1, 1); PG8_STAGE(PG8_SA(1, 0), a3, voffA);
            PG8_BAR; PG8_WAIT_L(0); PG8_MMA(1, 0, At, B0); PG8_BAR; PG8_SCHED;
            PG8_STAGE(PG8_SB(1, 1), b3 + hstep, voffB);
            PG8_WAIT_V(6); PG8_BAR; PG8_MMA(1, 1, At, B1); PG8_BAR;
            }
        }
        if constexpr (ALIGN_EPI) { if (wr == 0) PG8_BAR; }
        if (!Epi::AFTER_DRAIN || has_next) { E(acc, cur, wr, wc, fr, fq); S.done(cur); }
        if (!has_next) break;
#pragma unroll
        for (int a = 0; a < 2; ++a)
#pragma unroll
            for (int b = 0; b < 2; ++b)
#pragma unroll
                for (int m = 0; m < 4; ++m)
#pragma unroll
                    for (int n = 0; n < 2; ++n) acc[a][b][m][n] = (f32x4){0.f, 0.f, 0.f, 0.f};
        cur = nxt; cA = nA; cB = nB; ++ui;
        if constexpr (ALIGN_EPI) { if (wr == 1) PG8_BAR; }
    }
    PG8_WAIT_V(0);
    if constexpr (!ALIGN_EPI) { if (wr == 0) PG8_BAR; }
    PG8_BAR;
    if constexpr (Epi::AFTER_DRAIN) { E.fused(acc, cur, wr, wc, fr, fq, lds, wid, lane); S.done(cur); }
#undef PG8_SA
#undef PG8_SB
#undef PG8_STAGE
#undef PG8_LDA
#undef PG8_LDB
#undef PG8_MMA
#undef PG8_WAIT_V
#undef PG8_WAIT_L
#undef PG8_BAR
#undef PG8_SCHED
}
}
#ifndef MK_N_LAUNCHES
#define MK_N_LAUNCHES 1
#endif
constexpr int N_LAUNCHES = MK_N_LAUNCHES;
constexpr int N_PHASES = 9;
#define LAS __attribute__((address_space(3)))
typedef unsigned short bf16;
typedef unsigned v4u __attribute__((ext_vector_type(4)));
typedef unsigned v2u __attribute__((ext_vector_type(2)));
typedef float f32x4 __attribute__((ext_vector_type(4)));
typedef short bf16x8 __attribute__((ext_vector_type(8)));
#define LDS_WAIT() asm volatile("s_waitcnt lgkmcnt(0)" ::: "memory")
#define MFMA16(a, b, c) __builtin_amdgcn_mfma_f32_16x16x32_bf16((a), (b), (c), 0, 0, 0)

constexpr int D = 1024, SEQ = 2048, NBATCH = 8, TP = 2112  , MP1 = NBATCH * TP  , M1 = 17408, M2 = 16896;
constexpr int NZ = 3584, INW = 3592, FF = 4096, NCHUNK = 33, NITEM = NBATCH * NCHUNK * 4  ;
constexpr float EPS = 1e-6f;
constexpr size_t OUT_YS = 16777216, OUT_CAP = 17301504, OUT_CQP = 17309696, OUT_SSP = 17346560, OUT_CAS = 17870848, OUT_CQS = 18001920, OUT_SSS = 18591744;
constexpr size_t MiB = 1u << 20;
constexpr size_t WS_RS0 = 0, WS_AB = 128 * 1024, WS_SSPART = 768 * 1024, WS_EG = 1920 * 1024;
constexpr size_t WS_WIN = 2 * MiB, WS_WOUT = 9 * MiB, WS_WUP = 11 * MiB, WS_WDN = 19 * MiB;
constexpr size_t WS_YMIX = 27 * MiB;
constexpr size_t WS_Z = 61 * MiB;
constexpr size_t WS_CH = 180 * MiB;
constexpr size_t WS_UF = 61 * MiB;
constexpr size_t WS_A2 = 193 * MiB;
constexpr size_t WS_END = 256 * MiB;
static_assert(WS_CH + (size_t)NITEM * 73728 <= WS_END && WS_Z + (size_t)M1 * NZ * 2 <= WS_CH && WS_YMIX + (size_t)M1 * D * 2 <= WS_Z && WS_UF + (size_t)M2 * FF * 2 <= WS_A2 && WS_A2 + (size_t)M2 * D * 2 <= WS_END, "ws map");
constexpr int CH_ITEM = 73728, OFF_NW = 0, OFF_QD = 16384, OFF_KDT = 32768, OFF_QK = 49152, OFF_U = 57344;
constexpr int LDS_BYTES = 147456 + 64;
constexpr int LDS_BAR_OFF = 147456;
constexpr size_t WS_RDY = 2000 * 1024;
constexpr size_t WS_PCNT = 2008 * 1024;
constexpr size_t WS_BAR = 1984 * 1024;
constexpr int NKS7 = 8;

__device__ __forceinline__ float bf2f(unsigned short b) { return __builtin_bit_cast(float, (unsigned)b << 16); }
__device__ __forceinline__ float bflo(unsigned w) { return __builtin_bit_cast(float, w << 16); }
__device__ __forceinline__ float bfhi(unsigned w) { return __builtin_bit_cast(float, w & 0xffff0000u); }
__device__ __forceinline__ unsigned pk2(float lo, float hi) { return pg8::cvt_pk_bf16(lo, hi); }
__device__ __forceinline__ bf16x8 pack8(const f32x4& a, const f32x4& b) { const v4u p = (v4u){pk2(a[0], a[1]), pk2(a[2], a[3]), pk2(b[0], b[1]), pk2(b[2], b[3])}; return __builtin_bit_cast(bf16x8, p); }
__device__ __forceinline__ float wave_sum(float v) {
#pragma unroll
    for (int o = 1; o < 64; o <<= 1) v += __shfl_xor(v, o);
    return v;
}
__device__ __forceinline__ float siluf(float x) { return x * __builtin_amdgcn_rcpf(1.0f + __expf(-x)); }
__device__ __forceinline__ float softplusf(float x) { return x > 20.f ? x : log1pf(__expf(x)); }

__device__ __forceinline__ void p0_transpose_item(const float* W, int ldw, int nblk, int K, bf16* WT, LAS float* scr, int item, int lane) {
    const int kb = item / nblk, nb = item % nblk, k0 = 64 * kb, n0 = 32 * nb;
#pragma unroll 8
    for (int i = 0; i < 32; ++i) { const int kk = 2 * i + (lane >> 5); scr[kk * 33 + (lane & 31)] = W[(size_t)(k0 + kk) * ldw + n0 + (lane & 31)]; }
    LDS_WAIT(); asm volatile("" ::: "memory");
    const int c = lane & 7;
#pragma unroll
    for (int j = 0; j < 4; ++j) { const int n = (lane >> 3) + 8 * j; const LAS float* s = scr + (8 * c) * 33 + n;
        v4u o; o.x = pk2(s[0 * 33], s[1 * 33]); o.y = pk2(s[2 * 33], s[3 * 33]); o.z = pk2(s[4 * 33], s[5 * 33]); o.w = pk2(s[6 * 33], s[7 * 33]);
        *(v4u*)(WT + (size_t)(n0 + n) * K + k0 + 8 * c) = o; }
    LDS_WAIT(); asm volatile("" ::: "memory");
}

struct Args { const float* in[18]; float* out; unsigned char* ws; int ph_lo, ph_hi, dry, pad; };

__device__ __forceinline__ void late_weights(const Args& a, LAS float* scr, int gwi, int ngw, int lane) {
    constexpr int I_OUT = 16 * 32, I_UP = 16 * 128, I_DN = 64 * 32;
    unsigned char* ws = a.ws;
    for (int it = gwi; it < I_OUT + I_UP + I_DN; it += ngw) {
        int r = it;
        if (r < I_OUT) { p0_transpose_item(a.in[13], 1024, 32, 1024, (bf16*)(ws + WS_WOUT), scr, r, lane); continue; } r -= I_OUT;
        if (r < I_UP) { p0_transpose_item(a.in[15], FF, 128, 1024, (bf16*)(ws + WS_WUP), scr, r, lane); continue; } r -= I_UP;
        p0_transpose_item(a.in[16], 1024, 32, FF, (bf16*)(ws + WS_WDN), scr, r, lane);
    }
}
__device__ __forceinline__ void p0_prologue(const Args& a, LAS unsigned char* lds, int gw, int NGW, int wave, int lane) {
    unsigned char* ws = a.ws;
    LAS float* scr = (LAS float*)(lds + wave * 16384);
    for (int it = gw; it < 16 * 112; it += NGW) p0_transpose_item(a.in[7], INW, 112, 1024, (bf16*)(ws + WS_WIN), scr, it, lane);
    const float* xp = a.in[0]; const float* xs = a.in[1]; const float* meta = a.in[5]; const float* gm = a.in[6]; const float* win = a.in[7];
    f32x4 g4[4];
#pragma unroll
    for (int j = 0; j < 4; ++j) g4[j] = *(const f32x4*)(gm + 256 * j + 4 * lane);
    f32x4 w8[4][4][2];
#pragma unroll
    for (int j = 0; j < 4; ++j)
#pragma unroll
        for (int e = 0; e < 4; ++e) { const float* wp = win + (size_t)(256 * j + 4 * lane + e) * INW + 3584; w8[j][e][0] = *(const f32x4*)wp; w8[j][e][1] = *(const f32x4*)(wp + 4); }
    bf16* A0 = (bf16*)(ws + WS_YMIX); float* RS0 = (float*)(ws + WS_RS0); float* AB = (float*)(ws + WS_AB);
    auto row_src = [&](int r) -> const float* {
        if (r >= M1) return nullptr;
        if (r < MP1) { const int b = r / TP, p = r - b * TP; if (p >= 64) return xp + ((size_t)b * SEQ + (p - 64)) * D; if (p >= 48) return meta + (size_t)(p - 48) * D; return nullptr; }
        return xs + (size_t)(r - MP1) * D; };
    auto row_finish = [&](int r, const float* src, const f32x4 (&v)[4]) {
        if (r >= M1) return;
        v2u* orow = (v2u*)(A0 + (size_t)r * D) + lane;
        if (!src) {
#pragma unroll
            for (int j = 0; j < 4; ++j) orow[64 * j] = (v2u){0u, 0u};
            if (lane == 0) RS0[r] = 0.f;
            if (lane < 8) AB[(size_t)r * 8 + lane] = 0.f;
            return;
        }
        float ss = 0.f;
#pragma unroll
        for (int j = 0; j < 4; ++j) ss += (v[j][0] * v[j][0] + v[j][1] * v[j][1]) + (v[j][2] * v[j][2] + v[j][3] * v[j][3]);
        const float rinv = 1.0f / sqrtf(wave_sum(ss) * (1.0f / D) + EPS);
        f32x4 ab0 = {0.f, 0.f, 0.f, 0.f}, ab1 = {0.f, 0.f, 0.f, 0.f};
#pragma unroll
        for (int j = 0; j < 4; ++j) { const f32x4 gx = v[j] * g4[j]; orow[64 * j] = (v2u){pk2(gx[0], gx[1]), pk2(gx[2], gx[3])};
#pragma unroll
            for (int e = 0; e < 4; ++e) { ab0 += w8[j][e][0] * gx[e]; ab1 += w8[j][e][1] * gx[e]; } }
        float abv[8];
#pragma unroll
        for (int c = 0; c < 4; ++c) { abv[c] = wave_sum(ab0[c]) * rinv; abv[4 + c] = wave_sum(ab1[c]) * rinv; }
        if (lane == 0) { RS0[r] = rinv; *(f32x4*)(AB + (size_t)r * 8) = (f32x4){abv[0], abv[1], abv[2], abv[3]}; *(f32x4*)(AB + (size_t)r * 8 + 4) = (f32x4){abv[4], abv[5], abv[6], abv[7]}; } };
    for (int r = gw; r < M1; r += 2 * NGW) {
        const float* sA = row_src(r); const float* sB = row_src(r + NGW);
        f32x4 vA[4], vB[4];
#pragma unroll
        for (int j = 0; j < 4; ++j) { vA[j] = sA ? *((const f32x4*)sA + 64 * j + lane) : (f32x4){0.f, 0.f, 0.f, 0.f}; vB[j] = sB ? *((const f32x4*)sB + 64 * j + lane) : (f32x4){0.f, 0.f, 0.f, 0.f}; }
        row_finish(r, sA, vA); row_finish(r + NGW, sB, vB);
    }
}
#define GAS __attribute__((address_space(1)))
#define XB_TMO      128
#define XB_XCNT(j)  (256  + 64 * (j))
#define XB_XSUB(j)  (1280 + 64 * (j))
#define XB_XGEN(j)  (2304 + 64 * (j))
#define XB_TOP      3328
#define XB_TOPGEN   3392
#define XCD_BAR_WORDS 3456
#define XB_SPIN_CAP (1u << 18)

__device__ __forceinline__ unsigned xb_ld(unsigned* p)              { return __hip_atomic_load(p, __ATOMIC_RELAXED, __HIP_MEMORY_SCOPE_AGENT); }
__device__ __forceinline__ unsigned xb_add(unsigned* p, unsigned v) { return __hip_atomic_fetch_add(p, v, __ATOMIC_RELAXED, __HIP_MEMORY_SCOPE_AGENT); }
__device__ __forceinline__ unsigned xb_xcc_id() { return (unsigned)__builtin_amdgcn_s_getreg((3 << 11) | 20) & 0xFu; }
#define XB_SPIN(cond, bar) do { unsigned _sp = 0; while (cond) { __builtin_amdgcn_s_sleep(1); \
    if ((++_sp & 255u) == 0u) { if (xb_ld(&(bar)[XB_TMO])) break; if (_sp > XB_SPIN_CAP) { atomicAdd(&(bar)[XB_TMO], 1u); break; } } } } while (0)

struct XcdBarrier {
    unsigned* bar; unsigned x;
    volatile LAS unsigned* st;
};

__device__ __forceinline__ XcdBarrier xcd_barrier_post(unsigned* bar, volatile LAS unsigned* st) {
    XcdBarrier b; b.bar = bar; b.x = xb_xcc_id(); b.st = st;
    if (threadIdx.x == 0) (void)xb_add(&bar[XB_XCNT(b.x)], 1u);
    return b;
}
__device__ __forceinline__ void xcd_barrier_complete(unsigned* bar, unsigned x, unsigned& nloc, unsigned& nx) {
    const unsigned G = gridDim.x * gridDim.y * gridDim.z;
    unsigned sum, cnt, mine, sp = 0u;
    for (;;) {
        sum = 0u; cnt = 0u; mine = 0u;
#pragma unroll
        for (unsigned j = 0; j < 16; ++j) { const unsigned c = xb_ld(&bar[XB_XCNT(j)]); sum += c; cnt += (c > 0u) ? 1u : 0u; mine = (j == x) ? c : mine; }
        if (sum == G) break;
        __builtin_amdgcn_s_sleep(1);
        if ((++sp & 255u) == 0u) { if (xb_ld(&bar[XB_TMO])) break; if (sp > XB_SPIN_CAP) { atomicAdd(&bar[XB_TMO], 1u); break; } }
    }
    nloc = mine > 0u ? mine : 1u; nx = cnt > 0u ? cnt : 1u;
}

__device__ __forceinline__ void xcd_barrier(const XcdBarrier& b) {
    asm volatile("s_waitcnt vmcnt(0)" ::: "memory");
    __syncthreads();
    if (threadIdx.x == 0) {
        unsigned* bar = b.bar;
        __builtin_amdgcn_s_waitcnt(0);
        unsigned nloc = b.st[0], nx = b.st[1];
        if (nloc == 0u) { xcd_barrier_complete(bar, b.x, nloc, nx); b.st[0] = nloc; b.st[1] = nx; }
        const unsigned old = xb_add(&bar[XB_XSUB(b.x)], 1u);
        const unsigned gen = old / nloc;
        if (old + 1u == (gen + 1u) * nloc) {
            __builtin_amdgcn_fence(__ATOMIC_RELEASE, "agent");
            asm volatile("s_waitcnt vmcnt(0)" ::: "memory");
            const unsigned og = xb_add(&bar[XB_TOP], 1u);
            const unsigned tg = og / nx;
            if (og + 1u == (tg + 1u) * nx) xb_add(&bar[XB_TOPGEN], 1u);
            else XB_SPIN(xb_ld(&bar[XB_TOPGEN]) == tg, bar);
            __builtin_amdgcn_fence(__ATOMIC_ACQUIRE, "agent");
            xb_add(&bar[XB_XGEN(b.x)], 1u);
            asm volatile("s_waitcnt vmcnt(0)" ::: "memory");
        } else {
            XB_SPIN(xb_ld(&bar[XB_XGEN(b.x)]) == gen, bar);
            __builtin_amdgcn_fence(__ATOMIC_ACQUIRE, "agent");
            asm volatile("s_waitcnt vmcnt(0)" ::: "memory");
        }
    }
    __syncthreads();
}

constexpr int TCW = 32, TNQ = TCW / 4;
__host__ __device__ constexpr int tinv_count(int i) { int n = 0; for (int r = 1; r < i; ++r) n += (r + TCW - 1) / TCW; return n; }
template <int I, int HH, int NR> __device__ __forceinline__ void tinv_chunk(float (&x)[NR], f32x4 (&lbuf)[2][TNQ], const LAS float* LM, float& acc) {
    if constexpr (TCW * HH < I) {
        constexpr int par = (tinv_count(I) + HH) & 1;
        constexpr bool lasth = !(TCW * (HH + 1) < I);
        constexpr int ni = lasth ? I + 1 : I, nh = lasth ? 0 : HH + 1;
        if constexpr (ni < NR) {
#pragma unroll
            for (int q = 0; q < TNQ; ++q) { if (TCW * nh + 4 * q < ni) lbuf[par ^ 1][q] = *(const LAS f32x4*)(LM + ni * 64 + TCW * nh + 4 * q); }
        }
        asm volatile("" ::: "memory");
#pragma unroll
        for (int q = 0; q < TNQ; ++q) { const int m4 = TCW * HH + 4 * q; if (m4 < I) { const f32x4 l = lbuf[par][q];
            acc -= l[0] * x[m4]; if (m4 + 1 < I) acc -= l[1] * x[m4 + 1]; if (m4 + 2 < I) acc -= l[2] * x[m4 + 2]; if (m4 + 3 < I) acc -= l[3] * x[m4 + 3]; } }
        tinv_chunk<I, HH + 1, NR>(x, lbuf, LM, acc);
    }
}
template <int I, int NR> __device__ __forceinline__ void tinv_rows(float (&x)[NR], f32x4 (&lbuf)[2][TNQ], const LAS float* LM) {
    if constexpr (I < NR) { float acc = x[I]; tinv_chunk<I, 0, NR>(x, lbuf, LM, acc); x[I] = acc; tinv_rows<I + 1, NR>(x, lbuf, LM); }
}
__device__ __forceinline__ void p2_ya_item(int idx, const bf16* Z, const float* st_a, const float* cwa, bf16* YMIX) {
    const int r2 = idx >> 6, cgp = idx & 63, c0 = 8 * cgp;
    float ch[3][8];
    int r1;
    if (r2 < 16384) { const int b = r2 >> 11, t = r2 & 2047; r1 = b * TP + 64 + t;
#pragma unroll
        for (int j = 0; j < 3; ++j) { const v4u zc = *(const v4u*)(Z + (size_t)(r1 - 2 + j) * NZ + 512 + c0), zh = *(const v4u*)(Z + (size_t)(r1 - 2 + j) * NZ + 1024 + c0);
            ch[j][0] = bflo(zc.x) * bflo(zh.x); ch[j][1] = bfhi(zc.x) * bfhi(zh.x); ch[j][2] = bflo(zc.y) * bflo(zh.y); ch[j][3] = bfhi(zc.y) * bfhi(zh.y);
            ch[j][4] = bflo(zc.z) * bflo(zh.z); ch[j][5] = bfhi(zc.z) * bfhi(zh.z); ch[j][6] = bflo(zc.w) * bflo(zh.w); ch[j][7] = bfhi(zc.w) * bfhi(zh.w); }
    } else { const int sidx = r2 - 16384, s = sidx >> 2, t = sidx & 3; r1 = MP1 + sidx;
#pragma unroll
        for (int j = 0; j < 3; ++j) { const int pos = t - 2 + j;
            if (pos < 0) { const f32x4 s0 = *(const f32x4*)(st_a + (size_t)(s * 2 + pos + 2) * 512 + c0), s1 = *(const f32x4*)(st_a + (size_t)(s * 2 + pos + 2) * 512 + c0 + 4);
                ch[j][0] = s0[0]; ch[j][1] = s0[1]; ch[j][2] = s0[2]; ch[j][3] = s0[3]; ch[j][4] = s1[0]; ch[j][5] = s1[1]; ch[j][6] = s1[2]; ch[j][7] = s1[3]; }
            else { const size_t rr = (size_t)(MP1 + s * 4 + pos); const v4u zc = *(const v4u*)(Z + rr * NZ + 512 + c0), zh = *(const v4u*)(Z + rr * NZ + 1024 + c0);
                ch[j][0] = bflo(zc.x) * bflo(zh.x); ch[j][1] = bfhi(zc.x) * bfhi(zh.x); ch[j][2] = bflo(zc.y) * bflo(zh.y); ch[j][3] = bfhi(zc.y) * bfhi(zh.y);
                ch[j][4] = bflo(zc.z) * bflo(zh.z); ch[j][5] = bfhi(zc.z) * bfhi(zh.z); ch[j][6] = bflo(zc.w) * bflo(zh.w); ch[j][7] = bfhi(zc.w) * bfhi(zh.w); } }
    }
    float y[8];
#pragma unroll
    for (int e = 0; e < 8; ++e) y[e] = 0.f;
#pragma unroll
    for (int j = 0; j < 3; ++j) { const f32x4 w0 = *(const f32x4*)(cwa + j * 512 + c0), w1 = *(const f32x4*)(cwa + j * 512 + c0 + 4);
        y[0] += w0[0] * ch[j][0]; y[1] += w0[1] * ch[j][1]; y[2] += w0[2] * ch[j][2]; y[3] += w0[3] * ch[j][3]; y[4] += w1[0] * ch[j][4]; y[5] += w1[1] * ch[j][5]; y[6] += w1[2] * ch[j][6]; y[7] += w1[3] * ch[j][7]; }
    const v4u zb = *(const v4u*)(Z + (size_t)r1 * NZ + c0);
    *(v4u*)(YMIX + (size_t)r2 * D + c0) = (v4u){pk2(y[0] * bflo(zb.x), y[1] * bfhi(zb.x)), pk2(y[2] * bflo(zb.y), y[3] * bfhi(zb.y)), pk2(y[4] * bflo(zb.z), y[5] * bfhi(zb.z)), pk2(y[6] * bflo(zb.w), y[7] * bfhi(zb.w))};
}
__device__ __forceinline__ void p2_state_item(int e, const bf16* Z, float* out) {
    int seq, k, rowbase; size_t oa, oq;
    if (e < NBATCH * 5632) { seq = e / 5632; k = e - seq * 5632; rowbase = seq * TP + 2112; oa = OUT_CAP; oq = OUT_CQP; }
    else { const int e2 = e - NBATCH * 5632; seq = e2 / 5632; k = e2 - seq * 5632; rowbase = MP1 + seq * 4 + 4; oa = OUT_CAS; oq = OUT_CQS; }
    if (k < 1024) { const int j = k >> 9, c = k & 511; const size_t row = (size_t)(rowbase - 2 + j);
        out[oa + (size_t)seq * 1024 + k] = bf2f(Z[row * NZ + 512 + c]) * bf2f(Z[row * NZ + 1024 + c]); }
    else { const int k2 = k - 1024, j = k2 / 1536, c = k2 - j * 1536; const size_t row = (size_t)(rowbase - 3 + j);
        out[oq + (size_t)seq * 4608 + k2] = bf2f(Z[row * NZ + 1536 + c]); }
}

typedef unsigned long long u64g;
__device__ __forceinline__ void wt_store16(__amdgpu_buffer_rsrc_t rsrc, unsigned off, v4u v) { __builtin_amdgcn_raw_buffer_store_b128(v, rsrc, off, 0,   16); }
__device__ __forceinline__ void wt_store8(unsigned char* p, v2u v) { __hip_atomic_store((u64g*)p, (u64g)v.x | ((u64g)v.y << 32), __ATOMIC_RELAXED, __HIP_MEMORY_SCOPE_AGENT); }
__device__ __forceinline__ void p2_publish(unsigned* RDY, int item) {
    __hip_atomic_store(RDY + item, 1u, __ATOMIC_RELAXED, __HIP_MEMORY_SCOPE_AGENT);
}
__device__ __forceinline__ void p2_chunk_item(LAS unsigned char* lds, int item, const bf16* Z, const float* AB, const float* convw, const float* a_log, const float* dt_bias,
                                              unsigned char* CH, float* EG, unsigned* RDY, int prev_item, int lane, int wave) {
    const int h = item & 3, bc = item >> 2, c = bc % NCHUNK, b = bc / NCHUNK;
    const int rbase = b * TP + 64 * c;
    LAS float* LM = (LAS float*)(lds); LAS float* GA = (LAS float*)(lds + 16384); LAS float* GC = GA + 64; LAS float* BE = GA + 128;
    LAS bf16* QS = (LAS bf16*)(lds + 17408); LAS bf16* KS = (LAS bf16*)(lds + 34816); LAS bf16* KT = (LAS bf16*)(lds + 52224); LAS bf16* VT = (LAS bf16*)(lds + 70656); LAS bf16* TM = (LAS bf16*)(lds + 89088);
    unsigned char* chi = CH + (size_t)item * CH_ITEM;
    const __amdgpu_buffer_rsrc_t chr = __builtin_amdgcn_make_buffer_rsrc(CH, 0, NITEM * CH_ITEM, 0x00020000);
    const unsigned cho = (unsigned)item * (unsigned)CH_ITEM;
    {
        const int i0 = wave * 8;
        int lnA = lane; asm volatile("" : "+v"(lnA));
        if (lnA < 48) {
            const int part = lnA >> 4, cgp = lnA & 15, colq = part * 512 + h * 128 + 8 * cgp;
            f32x4 cw[4][2];
#pragma unroll
            for (int j = 0; j < 4; ++j) { cw[j][0] = *(const f32x4*)(convw + j * 1536 + colq); cw[j][1] = *(const f32x4*)(convw + j * 1536 + colq + 4); }
            v4u zr[11];
#pragma unroll
            for (int k = 0; k < 11; ++k) { const int p = 64 * c + i0 - 3 + k;
                zr[k] = (p >= 0) ? *(const v4u*)(Z + (size_t)(rbase + i0 - 3 + k) * NZ + 1536 + colq) : (v4u){0u, 0u, 0u, 0u}; }
#pragma unroll
            for (int hh = 0; hh < 2; ++hh) {
                const int ib = i0 + 4 * hh;
                float av[4][8];
#pragma unroll
                for (int i = 0; i < 4; ++i) {
#pragma unroll
                    for (int e = 0; e < 8; ++e) av[i][e] = 0.f;
#pragma unroll
                    for (int j = 0; j < 4; ++j) { const v4u z = zr[4 * hh + i + j];
                        av[i][0] += cw[j][0][0] * bflo(z.x); av[i][1] += cw[j][0][1] * bfhi(z.x); av[i][2] += cw[j][0][2] * bflo(z.y); av[i][3] += cw[j][0][3] * bfhi(z.y);
                        av[i][4] += cw[j][1][0] * bflo(z.z); av[i][5] += cw[j][1][1] * bfhi(z.z); av[i][6] += cw[j][1][2] * bflo(z.w); av[i][7] += cw[j][1][3] * bfhi(z.w); }
                    float ss = 0.f;
#pragma unroll
                    for (int e = 0; e < 8; ++e) { av[i][e] = siluf(av[i][e]); ss += av[i][e] * av[i][e]; }
                    ss += __shfl_xor(ss, 1); ss += __shfl_xor(ss, 2); ss += __shfl_xor(ss, 4); ss += __shfl_xor(ss, 8);
                    const float sc = (part == 2) ? 1.0f : __builtin_amdgcn_rsqf(ss + EPS) * (part == 0 ? 0.08838834764831845f : 1.0f);
#pragma unroll
                    for (int e = 0; e < 8; ++e) av[i][e] *= sc;
                }
                if (part < 2) { LAS bf16* R = (part == 0) ? QS : KS;
#pragma unroll
                    for (int i = 0; i < 4; ++i) *(LAS v4u*)(R + (ib + i) * 136 + 8 * cgp) = (v4u){pk2(av[i][0], av[i][1]), pk2(av[i][2], av[i][3]), pk2(av[i][4], av[i][5]), pk2(av[i][6], av[i][7])}; }
                if (part >= 1) { LAS bf16* T = (part == 1) ? KT : VT;
#pragma unroll
                    for (int e = 0; e < 8; ++e) *(LAS v2u*)(T + (8 * cgp + e) * 72 + ib) = (v2u){pk2(av[0][e], av[1][e]), pk2(av[2][e], av[3][e])}; }
            }
        } else if (lnA < 56) {
            const int i = i0 + (lnA - 48); const size_t row = (size_t)(rbase + i);
            const float al = AB[row * 8 + h], bz = AB[row * 8 + 4 + h];
            float g = -__expf(a_log[h]) * softplusf(al + dt_bias[h]);
            if (c == 0 && i < 48) g = 0.f;
            GA[i] = g; BE[i] = __builtin_amdgcn_rcpf(1.0f + __expf(-bz));
        }
    }
    asm volatile("s_waitcnt vmcnt(0)" ::: "memory");
    __syncthreads();
    if (wave == 0) { float g = GA[lane];
#pragma unroll
        for (int o = 1; o < 64; o <<= 1) { const float t = __shfl_up(g, o); if (lane >= o) g += t; }
        GC[lane] = g; }
    __syncthreads();
    {
        int lnB = lane; asm volatile("" : "+v"(lnB)); const int n16 = lnB & 15, g4 = lnB >> 4, lane = lnB;
        const int jt = wave & 3;
#pragma unroll
        for (int ii = 0; ii < 2; ++ii) { const int it = (wave >> 2) * 2 + ii;
            f32x4 kk = {0.f, 0.f, 0.f, 0.f}, qk = {0.f, 0.f, 0.f, 0.f};
            if (it >= jt) {
#pragma unroll
                for (int ks = 0; ks < 4; ++ks) { const bf16x8 A = *(const LAS bf16x8*)(KS + (16 * jt + n16) * 136 + 32 * ks + 8 * g4);
                    const bf16x8 Bk = *(const LAS bf16x8*)(KS + (16 * it + n16) * 136 + 32 * ks + 8 * g4), Bq = *(const LAS bf16x8*)(QS + (16 * it + n16) * 136 + 32 * ks + 8 * g4);
                    kk = MFMA16(A, Bk, kk); qk = MFMA16(A, Bq, qk); }
                const int i = 16 * it + n16; const float Gi = GC[i], bi = BE[i]; const f32x4 Gj = *(const LAS f32x4*)(GC + 16 * jt + 4 * g4);
#pragma unroll
                for (int r = 0; r < 4; ++r) { const int j = 16 * jt + 4 * g4 + r; const float d = __expf(fminf(Gi - Gj[r], 0.f));
                    kk[r] = (i > j) ? bi * kk[r] * d : 0.f; qk[r] = (i >= j) ? qk[r] * d : 0.f; }
                *(LAS f32x4*)(LM + i * 64 + 16 * jt + 4 * g4) = kk;
            }
            wt_store8(chi + OFF_QK + ((size_t)((it * 2 + (jt >> 1)) * 64 + lane) * 8 + (jt & 1) * 4) * 2, (v2u){pk2(qk[0], qk[1]), pk2(qk[2], qk[3])});
        }
    }
    __syncthreads();
    LAS bf16* T11c = (LAS bf16*)(lds + 98304); LAS bf16* Xc = (LAS bf16*)(lds + 100864);
    if (wave < 2) {
        const LAS float* Lb = LM + wave * (32 * 64 + 32);
        float x[32];
        int ln = lane; asm volatile("" : "+v"(ln));
#pragma unroll
        for (int i = 0; i < 32; ++i) x[i] = (i == ln) ? 1.f : 0.f;
        f32x4 lbuf[2][TNQ];
        lbuf[0][0] = *(const LAS f32x4*)(Lb + 64);
        tinv_rows<1, 32>(x, lbuf, Lb);
        if (wave == 0) {
#pragma unroll
            for (int i = 0; i < 32; i += 2) { const unsigned w = pk2(x[i], x[i + 1]); TM[i * 72 + ln] = (bf16)(w & 0xffffu); TM[(i + 1) * 72 + ln] = (bf16)(w >> 16); }
            if (ln < 32) {
#pragma unroll
                for (int i = 0; i < 32; i += 8) *(LAS v4u*)(T11c + ln * 40 + i) = (v4u){pk2(x[i], x[i + 1]), pk2(x[i + 2], x[i + 3]), pk2(x[i + 4], x[i + 5]), pk2(x[i + 6], x[i + 7])}; }
        } else if (ln < 32) {
#pragma unroll
            for (int i = 0; i < 32; i += 2) { const unsigned w = pk2(x[i], x[i + 1]); TM[(32 + i) * 72 + 32 + ln] = (bf16)(w & 0xffffu); TM[(33 + i) * 72 + 32 + ln] = (bf16)(w >> 16); }
        }
    } else {
        int lnC = lane; asm volatile("" : "+v"(lnC)); const int n16 = lnC & 15, g4 = lnC >> 4, lane = lnC;
        const float glast = GC[63];
        for (int q = wave - 2; q < 32; q += 6) {
            if (q < 16) { const int mt = q >> 2, kb = q & 3, i = 16 * mt + n16; const float e = __expf(GC[i]);
                const v2u lo = *(const LAS v2u*)(QS + i * 136 + 32 * kb + 4 * g4), hi = *(const LAS v2u*)(QS + i * 136 + 32 * kb + 16 + 4 * g4);
                wt_store16(chr, cho + OFF_QD + (unsigned)((mt * 4 + kb) * 64 + lane) * 16u, (v4u){pk2(bflo(lo.x) * e, bfhi(lo.x) * e), pk2(bflo(lo.y) * e, bfhi(lo.y) * e), pk2(bflo(hi.x) * e, bfhi(hi.x) * e), pk2(bflo(hi.y) * e, bfhi(hi.y) * e)});
            } else { const int q2 = q - 16, mt8 = q2 >> 1, tb = q2 & 1, dk = 16 * mt8 + n16, t0 = 32 * tb + 4 * g4;
                const v2u lo = *(const LAS v2u*)(KT + dk * 72 + t0), hi = *(const LAS v2u*)(KT + dk * 72 + t0 + 16);
                const f32x4 G0 = *(const LAS f32x4*)(GC + t0), G1 = *(const LAS f32x4*)(GC + t0 + 16);
                float f0[4], f1[4];
#pragma unroll
                for (int r = 0; r < 4; ++r) { f0[r] = __expf(glast - G0[r]); f1[r] = __expf(glast - G1[r]); }
                wt_store16(chr, cho + OFF_KDT + (unsigned)((mt8 * 2 + tb) * 64 + lane) * 16u, (v4u){pk2(bflo(lo.x) * f0[0], bfhi(lo.x) * f0[1]), pk2(bflo(lo.y) * f0[2], bfhi(lo.y) * f0[3]), pk2(bflo(hi.x) * f1[0], bfhi(hi.x) * f1[1]), pk2(bflo(hi.y) * f1[2], bfhi(hi.y) * f1[3])});
            }
        }
        if (wave == 2 && lane == 0) __hip_atomic_store(EG + item, __expf(glast), __ATOMIC_RELAXED, __HIP_MEMORY_SCOPE_AGENT);
        if (wave == 7 && lane == 0 && prev_item >= 0) p2_publish(RDY, prev_item);
    }
    __syncthreads();
    if (wave < 4) {
        int lnX = lane; asm volatile("" : "+v"(lnX)); const int n16 = lnX & 15, g4 = lnX >> 4, mt = wave >> 1, nt = wave & 1;
        const f32x4 l0 = *(const LAS f32x4*)(LM + (32 + 16 * mt + n16) * 64 + 8 * g4), l1 = *(const LAS f32x4*)(LM + (32 + 16 * mt + n16) * 64 + 8 * g4 + 4);
        const bf16x8 A = pack8(l0, l1), B = *(const LAS bf16x8*)(T11c + (16 * nt + n16) * 40 + 8 * g4);
        const f32x4 acc = MFMA16(A, B, ((f32x4){0.f, 0.f, 0.f, 0.f}));
        *(LAS v2u*)(Xc + (16 * nt + n16) * 40 + 16 * mt + 4 * g4) = (v2u){pk2(acc[0], acc[1]), pk2(acc[2], acc[3])};
    }
    __syncthreads();
    if (wave < 4) {
        int lnY = lane; asm volatile("" : "+v"(lnY)); const int n16 = lnY & 15, g4 = lnY >> 4, mt = wave >> 1, nt = wave & 1;
        const bf16x8 A = *(const LAS bf16x8*)(TM + (32 + 16 * mt + n16) * 72 + 32 + 8 * g4), B = *(const LAS bf16x8*)(Xc + (16 * nt + n16) * 40 + 8 * g4);
        const f32x4 acc = MFMA16(A, B, ((f32x4){0.f, 0.f, 0.f, 0.f}));
        const unsigned w0 = pk2(-acc[0], -acc[1]), w1 = pk2(-acc[2], -acc[3]);
        LAS bf16* tp = TM + (32 + 16 * mt + 4 * g4) * 72 + 16 * nt + n16;
        tp[0] = (bf16)(w0 & 0xffffu); tp[72] = (bf16)(w0 >> 16); tp[144] = (bf16)(w1 & 0xffffu); tp[216] = (bf16)(w1 >> 16);
    }
    __syncthreads();
    {
        int lnD = lane; asm volatile("" : "+v"(lnD)); const int n16 = lnD & 15, g4 = lnD >> 4, lane = lnD;
        bf16x8 Bv[2];
#pragma unroll
        for (int ks = 0; ks < 2; ++ks) { const v4u raw = *(const LAS v4u*)(VT + (16 * wave + n16) * 72 + 32 * ks + 8 * g4);
            const f32x4 b0 = *(const LAS f32x4*)(BE + 32 * ks + 8 * g4), b1 = *(const LAS f32x4*)(BE + 32 * ks + 8 * g4 + 4);
            const v4u pk = (v4u){pk2(bflo(raw.x) * b0[0], bfhi(raw.x) * b0[1]), pk2(bflo(raw.y) * b0[2], bfhi(raw.y) * b0[3]), pk2(bflo(raw.z) * b1[0], bfhi(raw.z) * b1[1]), pk2(bflo(raw.w) * b1[2], bfhi(raw.w) * b1[3])};
            Bv[ks] = __builtin_bit_cast(bf16x8, pk); }
#pragma unroll
        for (int mt = 0; mt < 4; ++mt) { f32x4 acc = {0.f, 0.f, 0.f, 0.f};
#pragma unroll
            for (int ks = 0; ks < 2; ++ks) { const bf16x8 A = *(const LAS bf16x8*)(TM + (16 * mt + n16) * 72 + 32 * ks + 8 * g4); acc = MFMA16(A, Bv[ks], acc); }
            wt_store8(chi + OFF_U + (size_t)((wave * 4 + mt) * 64 + lane) * 8, (v2u){pk2(acc[0], acc[1]), pk2(acc[2], acc[3])}); }
        const int kb = wave & 3;
        bf16x8 Aw[2][2];
#pragma unroll
        for (int dd = 0; dd < 2; ++dd)
#pragma unroll
            for (int ks = 0; ks < 2; ++ks) { const int t0 = 32 * ks + 8 * g4; const v4u raw = *(const LAS v4u*)(KT + (16 * (2 * kb + dd) + n16) * 72 + t0);
                const f32x4 b0 = *(const LAS f32x4*)(BE + t0), b1 = *(const LAS f32x4*)(BE + t0 + 4), G0 = *(const LAS f32x4*)(GC + t0), G1 = *(const LAS f32x4*)(GC + t0 + 4);
                float f[8];
#pragma unroll
                for (int r = 0; r < 4; ++r) { f[r] = b0[r] * __expf(G0[r]); f[4 + r] = b1[r] * __expf(G1[r]); }
                const v4u pk = (v4u){pk2(bflo(raw.x) * f[0], bfhi(raw.x) * f[1]), pk2(bflo(raw.y) * f[2], bfhi(raw.y) * f[3]), pk2(bflo(raw.z) * f[4], bfhi(raw.z) * f[5]), pk2(bflo(raw.w) * f[6], bfhi(raw.w) * f[7])};
                Aw[dd][ks] = __builtin_bit_cast(bf16x8, pk); }
#pragma unroll
        for (int ii = 0; ii < 2; ++ii) { const int it = (wave >> 2) * 2 + ii; f32x4 a0 = {0.f, 0.f, 0.f, 0.f}, a1 = {0.f, 0.f, 0.f, 0.f};
#pragma unroll
            for (int ks = 0; ks < 2; ++ks) { const bf16x8 Bt = *(const LAS bf16x8*)(TM + (16 * it + n16) * 72 + 32 * ks + 8 * g4); a0 = MFMA16(Aw[0][ks], Bt, a0); a1 = MFMA16(Aw[1][ks], Bt, a1); }
            wt_store16(chr, cho + OFF_NW + (unsigned)((it * 4 + kb) * 64 + lane) * 16u, (v4u){pk2(-a0[0], -a0[1]), pk2(-a0[2], -a0[3]), pk2(-a1[0], -a1[1]), pk2(-a1[2], -a1[3])}); }
    }
    __syncthreads();
}

__device__ __forceinline__ void p3_dma(LAS unsigned char* dst, const unsigned char* chi, int wave, int lane) {
#pragma unroll
    for (int j = 0; j < 9; ++j) { const int k = wave * 9 + j; __builtin_amdgcn_global_load_lds((const unsigned*)(chi + k * 1024 + lane * 16), (LAS unsigned*)(dst + k * 1024), 16, 0, 0); }
}
__device__ __forceinline__ void p3_wait_item(unsigned* rdy) {
    unsigned sp = 0; while (__hip_atomic_load(rdy, __ATOMIC_RELAXED, __HIP_MEMORY_SCOPE_AGENT) == 0u) { __builtin_amdgcn_s_sleep(2); if (++sp > (1u << 22)) break; }
    __builtin_amdgcn_fence(__ATOMIC_ACQUIRE, "agent"); asm volatile("s_waitcnt vmcnt(0)" ::: "memory");
}
__device__ __forceinline__ void p3_chain_block(LAS unsigned char* lds, int bh, const unsigned char* CH, const float* EG, unsigned* RDY, float* O, float* ssm_out, int lane, int wave) {
    const int b = bh >> 2, h = bh & 3, n16 = lane & 15, g4 = lane >> 4;
    const int item0 = (b * NCHUNK) * 4 + h;
    f32x4 S[2][8];
#pragma unroll
    for (int q = 0; q < 2; ++q)
#pragma unroll
        for (int i = 0; i < 8; ++i) S[q][i] = (f32x4){0.f, 0.f, 0.f, 0.f};
    if (wave == 7 && lane == 0) { p3_wait_item(RDY + item0); p3_wait_item(RDY + item0 + 4); }
    __syncthreads();
    p3_dma(lds, CH + (size_t)item0 * CH_ITEM, wave, lane);
    asm volatile("s_waitcnt vmcnt(0)" ::: "memory");
    __syncthreads();
    for (int c = 0; c < NCHUNK; ++c) {
        if (c + 1 < NCHUNK) p3_dma(lds + ((c + 1) & 1) * CH_ITEM, CH + (size_t)(item0 + 4 * (c + 1)) * CH_ITEM, wave, lane);
        if (wave == 7 && lane == 0 && c + 2 < NCHUNK) p3_wait_item(RDY + item0 + 4 * (c + 2));
        if (wave < 4) {
            const LAS unsigned char* base = lds + (c & 1) * CH_ITEM + lane * 16;
            const float egl = EG[item0 + 4 * c];
            bf16x8 Sb[2][4];
#pragma unroll
            for (int q = 0; q < 2; ++q)
#pragma unroll
                for (int kb = 0; kb < 4; ++kb) Sb[q][kb] = pack8(S[q][2 * kb], S[q][2 * kb + 1]);
            f32x4 vn[2][4];
#pragma unroll
            for (int mt = 0; mt < 4; ++mt) {
#pragma unroll
                for (int q = 0; q < 2; ++q) { const v2u ur = *(const LAS v2u*)(lds + (c & 1) * CH_ITEM + OFF_U + (((2 * wave + q) * 4 + mt) * 64 + lane) * 8);
                    vn[q][mt] = (f32x4){bflo(ur.x), bfhi(ur.x), bflo(ur.y), bfhi(ur.y)}; }
#pragma unroll
                for (int kb = 0; kb < 4; ++kb) { const bf16x8 A = *(const LAS bf16x8*)(base + OFF_NW + (mt * 4 + kb) * 1024);
                    vn[0][mt] = MFMA16(A, Sb[0][kb], vn[0][mt]); vn[1][mt] = MFMA16(A, Sb[1][kb], vn[1][mt]); } }
            bf16x8 vb[2][2];
#pragma unroll
            for (int q = 0; q < 2; ++q) { vb[q][0] = pack8(vn[q][0], vn[q][1]); vb[q][1] = pack8(vn[q][2], vn[q][3]); }
            float* orow = O + (size_t)(b * TP + 64 * c + 4 * g4) * 512 + h * 128 + wave * 32 + n16;
#pragma unroll
            for (int mt = 0; mt < 4; ++mt) { f32x4 a0 = {0.f, 0.f, 0.f, 0.f}, a1 = {0.f, 0.f, 0.f, 0.f};
#pragma unroll
                for (int kb = 0; kb < 4; ++kb) { const bf16x8 A = *(const LAS bf16x8*)(base + OFF_QD + (mt * 4 + kb) * 1024); a0 = MFMA16(A, Sb[0][kb], a0); a1 = MFMA16(A, Sb[1][kb], a1); }
#pragma unroll
                for (int tb = 0; tb < 2; ++tb) { const bf16x8 A = *(const LAS bf16x8*)(base + OFF_QK + (mt * 2 + tb) * 1024); a0 = MFMA16(A, vb[0][tb], a0); a1 = MFMA16(A, vb[1][tb], a1); }
#pragma unroll
                for (int r = 0; r < 4; ++r) { orow[(size_t)(16 * mt + r) * 512] = a0[r]; orow[(size_t)(16 * mt + r) * 512 + 16] = a1[r]; } }
#pragma unroll
            for (int m8 = 0; m8 < 8; ++m8) { S[0][m8] = S[0][m8] * egl; S[1][m8] = S[1][m8] * egl;
#pragma unroll
                for (int tb = 0; tb < 2; ++tb) { const bf16x8 A = *(const LAS bf16x8*)(base + OFF_KDT + (m8 * 2 + tb) * 1024); S[0][m8] = MFMA16(A, vb[0][tb], S[0][m8]); S[1][m8] = MFMA16(A, vb[1][tb], S[1][m8]); } }
        }
        asm volatile("s_waitcnt vmcnt(0) lgkmcnt(0)" ::: "memory");
        __syncthreads();
    }
    if (wave < 4) {
        float* so = ssm_out + ((size_t)(b * 4 + h) * 128 + 4 * g4) * 128 + wave * 32 + n16;
#pragma unroll
        for (int m8 = 0; m8 < 8; ++m8)
#pragma unroll
            for (int r = 0; r < 4; ++r) { so[(size_t)(16 * m8 + r) * 128] = S[0][m8][r]; so[(size_t)(16 * m8 + r) * 128 + 16] = S[1][m8][r]; }
    }
}
__device__ __forceinline__ void p3_sample_item(LAS float* scr, int it, const bf16* Z, const float* AB, const float* st_qkv, const float* st_ssm, const float* convw,
                                               const float* a_log, const float* dt_bias, float* O, float* ssm_out, int lane) {
    const int half = it & 1, h = (it >> 1) & 3, s = it >> 3, r0 = MP1 + 4 * s;
    int chn[5] = {h * 128 + lane, h * 128 + 64 + lane, 512 + h * 128 + lane, 512 + h * 128 + 64 + lane, 1024 + h * 128 + half * 64 + lane};
    float val[4][5];
#pragma unroll
    for (int q = 0; q < 5; ++q) { float xp[7];
#pragma unroll
        for (int j = 0; j < 3; ++j) xp[j] = st_qkv[(size_t)(s * 3 + j) * 1536 + chn[q]];
#pragma unroll
        for (int t = 0; t < 4; ++t) xp[3 + t] = bf2f(Z[(size_t)(r0 + t) * NZ + 1536 + chn[q]]);
        float cw[4];
#pragma unroll
        for (int j = 0; j < 4; ++j) cw[j] = convw[j * 1536 + chn[q]];
#pragma unroll
        for (int t = 0; t < 4; ++t) { float a = 0.f;
#pragma unroll
            for (int j = 0; j < 4; ++j) a += cw[j] * xp[t + j];
            val[t][q] = siluf(a); } }
    float gt[4], bt[4];
#pragma unroll
    for (int t = 0; t < 4; ++t) {
        const float sq = 1.0f / sqrtf(wave_sum(val[t][0] * val[t][0] + val[t][1] * val[t][1]) + EPS) * 0.08838834764831845f;
        const float sk = 1.0f / sqrtf(wave_sum(val[t][2] * val[t][2] + val[t][3] * val[t][3]) + EPS);
        val[t][0] *= sq; val[t][1] *= sq; val[t][2] *= sk; val[t][3] *= sk;
        const float al = AB[(size_t)(r0 + t) * 8 + h], bz = AB[(size_t)(r0 + t) * 8 + 4 + h];
        gt[t] = __expf(-__expf(a_log[h]) * softplusf(al + dt_bias[h])); bt[t] = 1.0f / (1.0f + __expf(-bz)); }
    float S[128];
    const float* sp = st_ssm + (size_t)(s * 4 + h) * 16384 + half * 64 + lane;
#pragma unroll
    for (int d = 0; d < 128; ++d) S[d] = sp[(size_t)d * 128];
#pragma unroll
    for (int t = 0; t < 4; ++t) {
        scr[lane] = val[t][2]; scr[64 + lane] = val[t][3]; scr[128 + lane] = val[t][0]; scr[192 + lane] = val[t][1];
        LDS_WAIT();
        float ks = 0.f;
#pragma unroll
        for (int d = 0; d < 128; d += 4) { const f32x4 k4 = *(const volatile LAS f32x4*)(scr + d); ks += k4[0] * S[d]; ks += k4[1] * S[d + 1]; ks += k4[2] * S[d + 2]; ks += k4[3] * S[d + 3]; }
        const float a = gt[t], cc = bt[t] * (val[t][4] - a * ks);
        float o = 0.f;
#pragma unroll
        for (int d = 0; d < 128; d += 4) { const f32x4 k4 = *(const volatile LAS f32x4*)(scr + d), q4 = *(const volatile LAS f32x4*)(scr + 128 + d);
#pragma unroll
            for (int e = 0; e < 4; ++e) { S[d + e] = a * S[d + e] + k4[e] * cc; o += S[d + e] * q4[e]; } }
        O[(size_t)(r0 + t) * 512 + h * 128 + half * 64 + lane] = o;
        LDS_WAIT();
    }
    float* so = ssm_out + (size_t)(s * 4 + h) * 16384 + half * 64 + lane;
#pragma unroll
    for (int d = 0; d < 128; ++d) so[(size_t)d * 128] = S[d];
}
template <bool WT> __device__ __forceinline__ void p4_row_t(int r2, const float* O, const bf16* Z, const float* gn, bf16* YMIX, int lane) {
    const int r1 = (r2 < 16384) ? ((r2 >> 11) * TP + 64 + (r2 & 2047)) : (MP1 + (r2 - 16384));
    const int hd = lane >> 4, dv = (lane & 15) * 8;
    const f32x4 o0 = *(const f32x4*)(O + (size_t)r1 * 512 + hd * 128 + dv), o1 = *(const f32x4*)(O + (size_t)r1 * 512 + hd * 128 + dv + 4);
    float ss = (o0[0] * o0[0] + o0[1] * o0[1]) + (o0[2] * o0[2] + o0[3] * o0[3]) + (o1[0] * o1[0] + o1[1] * o1[1]) + (o1[2] * o1[2] + o1[3] * o1[3]);
    ss += __shfl_xor(ss, 1); ss += __shfl_xor(ss, 2); ss += __shfl_xor(ss, 4); ss += __shfl_xor(ss, 8);
    const float rinv = 1.0f / sqrtf(ss * (1.0f / 128.0f) + EPS);
    const f32x4 g0 = *(const f32x4*)(gn + dv), g1 = *(const f32x4*)(gn + dv + 4);
    const v4u zg = *(const v4u*)(Z + (size_t)r1 * NZ + 3072 + hd * 128 + dv);
    float y[8] = {o0[0] * g0[0] * siluf(bflo(zg.x)), o0[1] * g0[1] * siluf(bfhi(zg.x)), o0[2] * g0[2] * siluf(bflo(zg.y)), o0[3] * g0[3] * siluf(bfhi(zg.y)),
                  o1[0] * g1[0] * siluf(bflo(zg.z)), o1[1] * g1[1] * siluf(bfhi(zg.z)), o1[2] * g1[2] * siluf(bflo(zg.w)), o1[3] * g1[3] * siluf(bfhi(zg.w))};
    const v4u yv = (v4u){pk2(y[0] * rinv, y[1] * rinv), pk2(y[2] * rinv, y[3] * rinv), pk2(y[4] * rinv, y[5] * rinv), pk2(y[6] * rinv, y[7] * rinv)};
    if (WT) wt_store16(__builtin_amdgcn_make_buffer_rsrc(YMIX, 0, M2 * D * 2, 0x00020000), (unsigned)(((size_t)r2 * D + 512 + hd * 128 + dv) * 2), yv);
    else *(v4u*)(YMIX + (size_t)r2 * D + 512 + hd * 128 + dv) = yv;
}
__device__ __forceinline__ void p4_row(int r2, const float* O, const bf16* Z, const float* gn, bf16* YMIX, int lane) { p4_row_t<false>(r2, O, Z, gn, YMIX, lane); }

__global__ void __launch_bounds__(512, 2) hymba_fwd(Args args) {
    extern __shared__ __attribute__((aligned(16))) unsigned char lds_raw[];
    LAS unsigned char* lds = (LAS unsigned char*)lds_raw;
    const int tid = threadIdx.x, lane = tid & 63, wave = __builtin_amdgcn_readfirstlane(tid >> 6);
    const int G = gridDim.x, bx = blockIdx.x;
    const int gw = bx * 8 + wave, NGW = G * 8;
    unsigned char* ws = args.ws; float* out = args.out;
    const int lo = args.ph_lo, hi = args.ph_hi;
    bf16* Z = (bf16*)(ws + WS_Z); bf16* YMIX = (bf16*)(ws + WS_YMIX); float* AB = (float*)(ws + WS_AB); float* O = out;
#ifndef PHMASK
#define PHMASK 0x1ff
#endif
#define IN(k) (((PHMASK >> (k)) & 1) && lo <= (k) && (k) < hi)
    volatile LAS unsigned* bst = (volatile LAS unsigned*)(lds + LDS_BAR_OFF);
    XcdBarrier bar; bar.bar = (unsigned*)(ws + WS_BAR); bar.x = 0; bar.st = bst;
    if (hi - lo > 1) { if (tid < 2) bst[tid] = 0u; __syncthreads(); bar = xcd_barrier_post((unsigned*)(ws + WS_BAR), bst); }
    if (args.dry == 0x5a5a5a5a) cg::this_grid().sync();
#define SEAM(k) do { if (IN(k) && IN((k) + 1)) { xcd_barrier(bar); } } while (0)
    if (IN(0)) { p0_prologue(args, lds, gw, NGW, wave, lane); }
    SEAM(0);
    if (IN(1)) { pg8::Gemm g{(const pg8::bf16_t*)(ws + WS_YMIX), (const pg8::bf16_t*)(ws + WS_WIN), M1, NZ, D}; pg8::StaticOrder S; S.init(M1, NZ, G, bx, D);
        pg8::EpiZ E{(pg8::bf16_t*)Z, NZ, (const float*)(ws + WS_RS0)};
        pg8::gemm_phase<pg8::EpiZ, pg8::StaticOrder, true, true>(lds, g, S, E); }
    SEAM(1);
    if (IN(2)) {
        unsigned* RDY = (unsigned*)(ws + WS_RDY);
        if (bx < 32) { p3_chain_block(lds, bx, ws + WS_CH, (const float*)(ws + WS_EG), RDY, O, out + OUT_SSP, lane, wave); }
        else {
            int prev = -1;
            for (int sq = bx - 32; sq < NITEM; sq += G - 32) { const int c = sq >> 5, bh = sq & 31, it = ((bh >> 2) * NCHUNK + c) * 4 + (bh & 3);
                p2_chunk_item(lds, it, Z, AB, args.in[9], args.in[10], args.in[11], ws + WS_CH, (float*)(ws + WS_EG), RDY, prev, lane, wave); prev = it; }
            asm volatile("s_waitcnt vmcnt(0)" ::: "memory"); __syncthreads();
            if (tid == 0 && prev >= 0) p2_publish(RDY, prev);
            LAS float* scr = (LAS float*)(lds + wave * 1024);
            for (int it = (bx - 32) * 8 + wave; it < 1024; it += (G - 32) * 8) p3_sample_item(scr, it, Z, AB, args.in[3], args.in[4], args.in[9], args.in[10], args.in[11], O, out + OUT_SSS, lane);
            late_weights(args, (LAS float*)(lds + 8192 + wave * 16384), (bx - 32) * 8 + wave, (G - 32) * 8, lane);
            for (int idx = (bx - 32) * 512 + tid; idx < M2 * 64; idx += (G - 32) * 512) p2_ya_item(idx, Z, args.in[2], args.in[8], YMIX);
            for (int e = (bx - 32) * 512 + tid; e < (NBATCH + 128) * 5632; e += (G - 32) * 512) p2_state_item(e, Z, out);
        }
    }
    SEAM(2);
    if (IN(5)) { pg8::Gemm g{(const pg8::bf16_t*)YMIX, (const pg8::bf16_t*)(ws + WS_WOUT), M2, D, D}; pg8::StaticOrder S; S.init(16384, D, G, bx, D);
        { pg8::Unit u0; S.next(0, u0); unsigned* c5 = (unsigned*)(ws + WS_PCNT + 8192) + 16 * u0.pm; const int rb = u0.pm * 256 + u0.pn * 64 + wave * 8;
#pragma unroll
          for (int k4 = 0; k4 < 8; k4 += 4) {
#pragma unroll
              for (int k = 0; k < 4; ++k) p4_row_t<true>(rb + k4 + k, O, Z, args.in[12], YMIX, lane); }
          if (bx < 64) p4_row(16384 + bx * 8 + wave, O, Z, args.in[12], YMIX, lane);
          asm volatile("s_waitcnt vmcnt(0)" ::: "memory");
          if (lane == 0) __hip_atomic_fetch_add(c5, 1u, __ATOMIC_RELAXED, __HIP_MEMORY_SCOPE_AGENT);
          if (hi - lo > 1) { if (tid == 0) { unsigned sp = 0; while (__hip_atomic_load(c5, __ATOMIC_RELAXED, __HIP_MEMORY_SCOPE_AGENT) < 32u) { __builtin_amdgcn_s_sleep(2); if (++sp > (1u << 22)) break; }
                  __builtin_amdgcn_fence(__ATOMIC_ACQUIRE, "agent"); asm volatile("s_waitcnt vmcnt(0)" ::: "memory"); }
              __syncthreads(); } }
        pg8::EpiOut<false> E{args.in[0], args.in[1], out, (pg8::bf16_t*)(ws + WS_A2), args.in[14], (float*)(ws + WS_SSPART), (unsigned*)(ws + WS_PCNT)};
        pg8::gemm_phase<pg8::EpiOut<false>, pg8::StaticOrder, true, true>(lds, g, S, E); }
    SEAM(5);
    if (IN(6)) {
        if (bx < 8) {
            pg8::Gemm g5{(const pg8::bf16_t*)YMIX, (const pg8::bf16_t*)(ws + WS_WOUT), M2, D, D}; pg8::OneUnitOrder S5{64 + (bx >> 2), bx & 3, D / 64};
            pg8::EpiOut<true> E5{args.in[0], args.in[1], out, (pg8::bf16_t*)(ws + WS_A2), args.in[14], (float*)(ws + WS_SSPART), (unsigned*)(ws + WS_PCNT)};
            pg8::gemm_phase<pg8::EpiOut<true>, pg8::OneUnitOrder, true, true>(lds, g5, S5, E5); }
        pg8::Gemm g{(const pg8::bf16_t*)(ws + WS_A2), (const pg8::bf16_t*)(ws + WS_WUP), M2, FF, D}; pg8::SplitTailOrder S;
        S.init(16384, 512, FF, G, bx, D, 1, 8, (hi - lo > 1) ? (const unsigned*)(ws + WS_PCNT) : nullptr, 32u);
        pg8::EpiUp E{(pg8::bf16_t*)(ws + WS_UF), FF, (const float*)(ws + WS_SSPART)};
        pg8::gemm_phase<pg8::EpiUp, pg8::SplitTailOrder, true, true>(lds, g, S, E); }
    SEAM(6);
    if (IN(7)) { pg8::Gemm g{(const pg8::bf16_t*)(ws + WS_UF), (const pg8::bf16_t*)(ws + WS_WDN), M2, D, FF}; pg8::SplitTailOrder S; S.init(16384, 512, D, G, bx, FF, NKS7); S.tail_first = 1;
        pg8::EpiDownNorm E{out, (float*)(ws + WS_YMIX), 16384, 512, (const pg8::bf16_t*)(ws + WS_A2), args.in[14], args.in[17], (float*)(ws + WS_SSPART), (unsigned*)(ws + WS_PCNT), (unsigned*)(ws + WS_PCNT + 12288)};
        pg8::gemm_phase<pg8::EpiDownNorm, pg8::SplitTailOrder, true, true>(lds, g, S, E);
        if (bx >= 64 && bx < 128) {
            if (hi - lo > 1) { if (tid == 0) { unsigned* c8 = (unsigned*)(ws + WS_PCNT + 12288); unsigned sp = 0; while (__hip_atomic_load(c8, __ATOMIC_RELAXED, __HIP_MEMORY_SCOPE_AGENT) < 512u) { __builtin_amdgcn_s_sleep(2); if (++sp > (1u << 22)) break; }
                    __builtin_amdgcn_fence(__ATOMIC_ACQUIRE, "agent"); asm volatile("s_waitcnt vmcnt(0)" ::: "memory"); }
                __syncthreads(); }
            const int r = 16384 + (bx - 64) * 8 + wave; const float* gfin = args.in[17]; f32x4 v[4]; float ss = 0.f;
#pragma unroll
            for (int j = 0; j < 4; ++j) { const v2u w = *((const v2u*)(ws + WS_A2 + (size_t)r * D * 2) + 64 * j + lane); const f32x4 gq = *(const f32x4*)(args.in[14] + 256 * j + 4 * lane);
                v[j] = (f32x4){bflo(w.x) * __builtin_amdgcn_rcpf(gq[0]), bfhi(w.x) * __builtin_amdgcn_rcpf(gq[1]), bflo(w.y) * __builtin_amdgcn_rcpf(gq[2]), bfhi(w.y) * __builtin_amdgcn_rcpf(gq[3])};
                const f32x4* pp = (const f32x4*)(ws + WS_YMIX) + (size_t)(r - 16384) * 256 + 64 * j + lane;
#pragma unroll
                for (int ks = 0; ks < NKS7; ++ks) v[j] += pp[(size_t)ks * 512 * 256];
                ss += (v[j][0] * v[j][0] + v[j][1] * v[j][1]) + (v[j][2] * v[j][2] + v[j][3] * v[j][3]); }
            const float rinv = 1.0f / sqrtf(wave_sum(ss) * (1.0f / D) + EPS); f32x4* rp = (f32x4*)(out + (size_t)r * D) + lane;
#pragma unroll
            for (int j = 0; j < 4; ++j) rp[64 * j] = v[j] * rinv * *(const f32x4*)(gfin + 256 * j + 4 * lane); } }
#undef IN
#undef SEAM
}

#ifndef REP_MASK
#define REP_MASK 0
#endif
extern "C" void kernel_launch(void* const* d_in, const int* in_sizes, int n_in, void* d_out, int out_size, void* d_ws, size_t ws_size, hipStream_t stream) {
    static int grid = 0;
    if (grid == 0) {
        if (n_in != 18 || ws_size < WS_END) { fprintf(stderr, "kernel_launch: unexpected n_in %d / ws %zu\n", n_in, ws_size); grid = -1; return; }
        int dev = 0, cus = 0, per_cu = 0;
        if (hipGetDevice(&dev) != hipSuccess || hipDeviceGetAttribute(&cus, hipDeviceAttributeMultiprocessorCount, dev) != hipSuccess) { grid = -1; return; }
        if (hipFuncSetAttribute((const void*)hymba_fwd, hipFuncAttributeMaxDynamicSharedMemorySize, LDS_BYTES) != hipSuccess) { fprintf(stderr, "kernel_launch: hipFuncSetAttribute failed\n"); grid = -1; return; }
        if (hipOccupancyMaxActiveBlocksPerMultiprocessor(&per_cu, (const void*)hymba_fwd, 512, LDS_BYTES) != hipSuccess || per_cu < 1) { fprintf(stderr, "kernel_launch: occupancy query gave %d\n", per_cu); (void)hipGetLastError(); per_cu = 1; }
        grid = cus * per_cu;
        if (grid > 256) grid = 256;
    }
    if (grid < 0) return;
    Args a{};
    for (int i = 0; i < 18; ++i) a.in[i] = (const float*)d_in[i];
    a.out = (float*)d_out; a.ws = (unsigned char*)d_ws;
    if (hipMemsetAsync((char*)d_ws + WS_BAR, 0, 40960, stream) != hipSuccess) { fprintf(stderr, "kernel_launch: memset of the barrier / flag words failed\n"); return; }
    if (N_LAUNCHES == 1) {
        a.ph_lo = 0; a.ph_hi = N_PHASES;
        void* kargs[] = {&a};
        hipError_t e = hipLaunchCooperativeKernel((const void*)hymba_fwd, dim3(grid), dim3(512), kargs, LDS_BYTES, stream);
        if (e != hipSuccess) fprintf(stderr, "cooperative launch failed: %s (grid %d)\n", hipGetErrorString(e), grid);
    } else {
        for (int p = 0; p < N_PHASES; ++p) { a.ph_lo = p; a.ph_hi = p + 1;
            for (int rep = 0; rep < ((REP_MASK >> p) & 1) + 1; ++rep) { a.dry = (p == 7 && rep + 1 < ((REP_MASK >> p) & 1) + 1) ? 1 : 0; hipLaunchKernelGGL(hymba_fwd, dim3(grid), dim3(512), LDS_BYTES, stream, a); } }
    }
}
```

```cpp
#include <hip/hip_runtime.h>
#include <hip/hip_cooperative_groups.h>
#include <cstdio>
#include <cstdint>
namespace cg = cooperative_groups;
namespace pg8 {
#define PG8_LAS __attribute__((address_space(3)))
typedef unsigned short bf16_t;
typedef short bf16x8 __attribute__((ext_vector_type(8)));
typedef float f32x4 __attribute__((ext_vector_type(4)));
typedef unsigned u32x4 __attribute__((ext_vector_type(4)));
constexpr int BM = 256, BK = 64, HALF = 128, HTB = HALF * BK * 2  , STAGE_BYTES = 8 * HTB, NXCD = 8, WGM = 8;

__host__ __device__ __forceinline__ int lds_byte(int r, int c) { const int st = (r >> 4) * 2 + (c >> 5), rr = r & 15, cc = c & 31, ob = rr * 64 + cc * 2; return st * 1024 + (ob ^ (((ob >> 9) & 1) << 5)); }
__host__ __device__ __forceinline__ void stage_rc(int b, int& R, int& C) { const int st = b / 1024, sb = b % 1024, swz = sb ^ (((sb >> 9) & 1) << 5); R = (st >> 1) * 16 + swz / 64; C = (st & 1) * 32 + (swz % 64) / 2; }
__host__ __device__ __forceinline__ int perm32(int rho) { const int n = rho >> 4, i = rho & 15; return 8 * (i >> 2) + 4 * n + (i & 3); }

struct Unit { int pm, pn, k0, nt; };
struct Gemm { const bf16_t* A; const bf16_t* Bt; int M, N, K; };

struct StaticOrder {
    int nM, nN, nwg, G, c, ntk;
    __host__ __device__ void init(int M, int N, int G_, int c_, int K_) { nM = M / BM; nN = N / BM; nwg = nM * nN; G = G_; c = c_; ntk = K_ / BK; }
    __host__ __device__ __forceinline__ bool next(int i, Unit& u) const {
        const long L = (long)i * G + c; if (L >= nwg) return false;
        int wgid = (int)L; { const int q = nwg / NXCD, r = nwg % NXCD, xcd = wgid % NXCD, off = wgid / NXCD; wgid = (xcd < r ? xcd * (q + 1) : r * (q + 1) + (xcd - r) * q) + off; }
        const int nig = WGM * nN, gid = wgid / nig, fm = gid * WGM, gsz = (nM - fm) < WGM ? (nM - fm) : WGM;
        u.pm = fm + ((wgid % nig) % gsz); u.pn = (wgid % nig) / gsz; u.k0 = 0; u.nt = ntk; return true;
    }
    __device__ __forceinline__ void a_ready(const Unit&) const {}
    __device__ __forceinline__ void done(const Unit&) const {}
};
struct SplitTailOrder {
    StaticOrder base; int nfull, nN, nks, ntail, G, c, ntk, tail_first, coff; const unsigned* ready; unsigned need;
    __host__ __device__ void init(int Mfull, int Mtail, int N, int G_, int c_, int K_, int nks_, int coff_ = 0, const unsigned* ready_ = nullptr, unsigned need_ = 0u) { base.init(Mfull, N, G_, c_, K_); nfull = base.nwg; nN = N / BM; nks = nks_; ntail = (Mtail / BM) * nN * nks_; G = G_; c = c_; ntk = K_ / BK; tail_first = 0; coff = coff_; ready = ready_; need = need_; }
    __host__ __device__ __forceinline__ bool next(int i, Unit& u) const {
        long L = (long)i * G + c;
        if (tail_first) { const bool has_tail = c < ntail; if (i > (has_tail ? 1 : 0)) return false; L = (has_tail && i == 0) ? (long)nfull + c : (long)c; }
        int pm_, pn_, k0_, nt_;
        if (L < nfull) {
            int wgid = (int)L; { const int q = nfull / NXCD, r = nfull % NXCD, xcd = wgid % NXCD, off = wgid / NXCD; wgid = (xcd < r ? xcd * (q + 1) : r * (q + 1) + (xcd - r) * q) + off; }
            const int nig = WGM * nN, gid = wgid / nig, fm = gid * WGM, gsz = (base.nM - fm) < WGM ? (base.nM - fm) : WGM;
            pm_ = fm + ((wgid % nig) % gsz); pn_ = (wgid % nig) / gsz; k0_ = 0; nt_ = ntk;
        } else {
            const int m = (int)(L - nfull) - coff; if (m < 0 || m >= ntail) return false;
            const int ks = m % nks; pn_ = (m / nks) % nN; pm_ = base.nM + m / (nks * nN); nt_ = ntk / nks; k0_ = ks * nt_ * BK;
        }
        u.pm = pm_; u.pn = pn_; u.k0 = k0_; u.nt = nt_; return true;
    }
    __device__ __forceinline__ void a_ready(const Unit& u) const {
        if (ready && u.pm >= base.nM) {
            if (threadIdx.x < 64) { unsigned polls = 0;
                while ((unsigned)__builtin_amdgcn_readfirstlane(__hip_atomic_load(ready + 16 * u.pm, __ATOMIC_RELAXED, __HIP_MEMORY_SCOPE_AGENT)) < need) { __builtin_amdgcn_s_sleep(2); if (++polls > (1u << 22)) break; }
                __builtin_amdgcn_fence(__ATOMIC_ACQUIRE, "agent");
                asm volatile("s_waitcnt vmcnt(0)" ::: "memory"); }
            asm volatile("" ::: "memory"); __builtin_amdgcn_s_barrier(); asm volatile("" ::: "memory");
        }
    }
    __device__ __forceinline__ void done(const Unit&) const {}
};
struct OneUnitOrder {
    int pm, pn, ntk;
    __host__ __device__ __forceinline__ bool next(int i, Unit& u) const { if (i != 0) return false; u.pm = pm; u.pn = pn; u.k0 = 0; u.nt = ntk; return true; }
    __device__ __forceinline__ void a_ready(const Unit&) const {}
    __device__ __forceinline__ void done(const Unit&) const {}
};

typedef unsigned u32x2 __attribute__((ext_vector_type(2)));
typedef float cvt_f32x2 __attribute__((ext_vector_type(2)));
typedef __bf16 cvt_bf16x2 __attribute__((ext_vector_type(2)));
__device__ __forceinline__ unsigned cvt_pk_bf16(float lo, float hi) { const cvt_f32x2 v = {lo, hi}; const cvt_bf16x2 b = __builtin_convertvector(v, cvt_bf16x2); return __builtin_bit_cast(unsigned, b); }
struct EpiZ {
    static constexpr bool PERM = true, AFTER_DRAIN = false;
    bf16_t* O; int ldc; const float* rs;
    __device__ __forceinline__ void operator()(const f32x4 (&acc)[2][2][4][2], const Unit& u, int wr, int wc, int fr, int fq) const {
        const int row0 = u.pm * BM + wr * 64 + fr, col0 = u.pn * BM + wc * 32 + 8 * fq;
        float sv[2][4];
#pragma unroll
        for (int ai = 0; ai < 2; ++ai)
#pragma unroll
            for (int m = 0; m < 4; ++m) sv[ai][m] = rs[row0 + ai * HALF + m * 16];
#pragma unroll
        for (int ai = 0; ai < 2; ++ai)
#pragma unroll
            for (int m = 0; m < 4; ++m) { const int row = row0 + ai * HALF + m * 16; const float s = sv[ai][m]; bf16_t* rowp = O + (size_t)row * ldc + col0;
#pragma unroll
                for (int bj = 0; bj < 2; ++bj) { const f32x4 v0 = acc[ai][bj][m][0] * s, v1 = acc[ai][bj][m][1] * s;
                    u32x4 w; w.x = cvt_pk_bf16(v0[0], v0[1]); w.y = cvt_pk_bf16(v0[2], v0[3]); w.z = cvt_pk_bf16(v1[0], v1[1]); w.w = cvt_pk_bf16(v1[2], v1[3]);
                    *(u32x4*)(rowp + bj * HALF) = w; } }
    }
};
struct EpiUp {
    static constexpr bool PERM = true, AFTER_DRAIN = false;
    bf16_t* O; int ldc; const float* ssp;
    __device__ __forceinline__ void operator()(const f32x4 (&acc)[2][2][4][2], const Unit& u, int wr, int wc, int fr, int fq) const {
        const int row0 = u.pm * BM + wr * 64 + fr, col0 = u.pn * BM + wc * 32 + 8 * fq;
        f32x4 sp[2][4];
#pragma unroll
        for (int ai = 0; ai < 2; ++ai)
#pragma unroll
            for (int m = 0; m < 4; ++m) sp[ai][m] = *(const f32x4*)(ssp + (size_t)(row0 + ai * HALF + m * 16) * 16 + 4 * fq);
#pragma unroll
        for (int ai = 0; ai < 2; ++ai)
#pragma unroll
            for (int m = 0; m < 4; ++m) { const int row = row0 + ai * HALF + m * 16; const f32x4 t = sp[ai][m];
                float tt = (t[0] + t[1]) + (t[2] + t[3]); tt += __shfl_xor(tt, 16); tt += __shfl_xor(tt, 32);
                const float s = 1.0f / sqrtf(tt * (1.0f / 1024.0f) + 1e-6f);
                bf16_t* rowp = O + (size_t)row * ldc + col0;
#pragma unroll
                for (int bj = 0; bj < 2; ++bj) { f32x4 v0 = acc[ai][bj][m][0] * s, v1 = acc[ai][bj][m][1] * s;
#pragma unroll
                    for (int j = 0; j < 4; ++j) { v0[j] = v0[j] > 0.f ? v0[j] * v0[j] : 0.f; v1[j] = v1[j] > 0.f ? v1[j] * v1[j] : 0.f; }
                    u32x4 w; w.x = cvt_pk_bf16(v0[0], v0[1]); w.y = cvt_pk_bf16(v0[2], v0[3]); w.z = cvt_pk_bf16(v1[0], v1[1]); w.w = cvt_pk_bf16(v1[2], v1[3]);
                    *(u32x4*)(rowp + bj * HALF) = w; } }
    }
};
template <bool PUB> struct EpiOut {
    static constexpr bool PERM = false, AFTER_DRAIN = false;
    const float* xp; const float* xs; float* out; bf16_t* a2; const float* gf; float* ssp; unsigned* cnt;
    __device__ __forceinline__ void operator()(const f32x4 (&acc)[2][2][4][2], const Unit& u, int wr, int wc, int fr, int fq) const {
        const int row0 = u.pm * BM + wr * 64 + fr, col0 = u.pn * BM + wc * 32 + 4 * fq;
        f32x4 gv[2][2];
#pragma unroll
        for (int bj = 0; bj < 2; ++bj)
#pragma unroll
            for (int n = 0; n < 2; ++n) gv[bj][n] = *(const f32x4*)(gf + col0 + bj * HALF + n * 16);
#pragma unroll
        for (int ai = 0; ai < 2; ++ai) {
            f32x4 hv[4][2][2];
#pragma unroll
            for (int m = 0; m < 4; ++m) { const int row = row0 + ai * HALF + m * 16;
                const float* hin = (row < 16384 ? xp + (size_t)row * 1024 : xs + (size_t)(row - 16384) * 1024) + col0;
#pragma unroll
                for (int bj = 0; bj < 2; ++bj)
#pragma unroll
                    for (int n = 0; n < 2; ++n) hv[m][bj][n] = *(const f32x4*)(hin + bj * HALF + n * 16); }
#pragma unroll
            for (int m = 0; m < 4; ++m) { const int row = row0 + ai * HALF + m * 16;
                float* op = out + (size_t)row * 1024 + col0; bf16_t* ap = a2 + (size_t)row * 1024 + col0; float ss = 0.f;
#pragma unroll
                for (int bj = 0; bj < 2; ++bj)
#pragma unroll
                    for (int n = 0; n < 2; ++n) { const f32x4 h = hv[m][bj][n] + acc[ai][bj][m][n];
                        ss += (h[0] * h[0] + h[1] * h[1]) + (h[2] * h[2] + h[3] * h[3]);
                        const f32x4 av = h * gv[bj][n]; u32x2 w; w.x = cvt_pk_bf16(av[0], av[1]); w.y = cvt_pk_bf16(av[2], av[3]);
                        if (PUB) __hip_atomic_store((unsigned long long*)(ap + bj * HALF + n * 16), (unsigned long long)w.x | ((unsigned long long)w.y << 32), __ATOMIC_RELAXED, __HIP_MEMORY_SCOPE_AGENT); else *(u32x2*)(ap + bj * HALF + n * 16) = w; }
                ss += __shfl_xor(ss, 16); ss += __shfl_xor(ss, 32);
                if (fq == 0) { if (PUB) __hip_atomic_store(ssp + (size_t)row * 16 + u.pn * 4 + wc, ss, __ATOMIC_RELAXED, __HIP_MEMORY_SCOPE_AGENT); else ssp[(size_t)row * 16 + u.pn * 4 + wc] = ss; } }
            asm volatile("" ::: "memory"); }
        if (PUB) { asm volatile("s_waitcnt vmcnt(0)" ::: "memory"); if (fr == 0 && fq == 0) __hip_atomic_fetch_add(cnt + 16 * u.pm, 1u, __ATOMIC_RELAXED, __HIP_MEMORY_SCOPE_AGENT); }
    }
};
struct EpiAcc {
    static constexpr bool PERM = false, AFTER_DRAIN = false;
    float* out; float* part; int ntfull, row_tail, tail_rows, dry; const bf16_t* a2; const float* gf;
    __device__ __forceinline__ void operator()(const f32x4 (&acc)[2][2][4][2], const Unit& u, int wr, int wc, int fr, int fq) const {
        const int row0 = u.pm * BM + wr * 64 + fr, col0 = u.pn * BM + wc * 32 + 4 * fq;
        if (dry) { if (acc[0][0][0][0][0] == 1.2345e30f) out[0] = 0.f; }
        else if (u.nt == ntfull) {
            f32x4 rg[2][2];
#pragma unroll
            for (int bj = 0; bj < 2; ++bj)
#pragma unroll
                for (int n = 0; n < 2; ++n) { const f32x4 g = *(const f32x4*)(gf + col0 + bj * HALF + n * 16); rg[bj][n] = (f32x4){__builtin_amdgcn_rcpf(g[0]), __builtin_amdgcn_rcpf(g[1]), __builtin_amdgcn_rcpf(g[2]), __builtin_amdgcn_rcpf(g[3])}; }
#pragma unroll
            for (int ai = 0; ai < 2; ++ai) {
                u32x2 hv[4][2][2];
#pragma unroll
                for (int m = 0; m < 4; ++m) { const bf16_t* ap = a2 + (size_t)(row0 + ai * HALF + m * 16) * 1024 + col0;
#pragma unroll
                    for (int bj = 0; bj < 2; ++bj)
#pragma unroll
                        for (int n = 0; n < 2; ++n) hv[m][bj][n] = *(const u32x2*)(ap + bj * HALF + n * 16); }
#pragma unroll
                for (int m = 0; m < 4; ++m) { float* op = out + (size_t)(row0 + ai * HALF + m * 16) * 1024 + col0;
#pragma unroll
                    for (int bj = 0; bj < 2; ++bj)
#pragma unroll
                        for (int n = 0; n < 2; ++n) { const u32x2 w = hv[m][bj][n];
                            const f32x4 h2 = (f32x4){__builtin_bit_cast(float, w.x << 16), __builtin_bit_cast(float, w.x & 0xffff0000u), __builtin_bit_cast(float, w.y << 16), __builtin_bit_cast(float, w.y & 0xffff0000u)} * rg[bj][n];
                            *(f32x4*)(op + bj * HALF + n * 16) = h2 + acc[ai][bj][m][n]; } }
                asm volatile("" ::: "memory"); }
        } else {
            float* pb = part + (size_t)(u.k0 / (u.nt * BK)) * tail_rows * 1024;
#pragma unroll
            for (int ai = 0; ai < 2; ++ai)
#pragma unroll
                for (int m = 0; m < 4; ++m) { float* op = pb + (size_t)(row0 + ai * HALF + m * 16 - row_tail) * 1024 + col0;
#pragma unroll
                    for (int bj = 0; bj < 2; ++bj)
#pragma unroll
                        for (int n = 0; n < 2; ++n) *(f32x4*)(op + bj * HALF + n * 16) = acc[ai][bj][m][n]; }
        }
    }
};

struct EpiDownNorm {
    static constexpr bool PERM = false, AFTER_DRAIN = true;
    float* out; float* part; int row_tail, tail_rows; const bf16_t* a2; const float* gf; const float* gfin; float* xch; unsigned* cnt; unsigned* cnt_tail;
    __device__ __forceinline__ void operator()(const f32x4 (&acc)[2][2][4][2], const Unit& u, int wr, int wc, int fr, int fq) const {
        const int row0 = u.pm * BM + wr * 64 + fr, col0 = u.pn * BM + wc * 32 + 4 * fq;
        const __amdgpu_buffer_rsrc_t rs_p = __builtin_amdgcn_make_buffer_rsrc(part, 0, 0x7ffffff0, 0x00020000);
        const unsigned pbo = (unsigned)(u.k0 / (u.nt * BK)) * (unsigned)tail_rows * 4096u;
#pragma unroll
        for (int ai = 0; ai < 2; ++ai)
#pragma unroll
            for (int m = 0; m < 4; ++m) { const unsigned ro = pbo + ((unsigned)(row0 + ai * HALF + m * 16 - row_tail) * 1024u + (unsigned)col0) * 4u;
#pragma unroll
                for (int bj = 0; bj < 2; ++bj)
#pragma unroll
                    for (int n = 0; n < 2; ++n) __builtin_amdgcn_raw_buffer_store_b128(__builtin_bit_cast(u32x4, acc[ai][bj][m][n]), rs_p, ro + (unsigned)(bj * HALF + n * 16) * 4u, 0, 16); }
        asm volatile("s_waitcnt vmcnt(0)" ::: "memory");
        if (fr == 0 && fq == 0) __hip_atomic_fetch_add(cnt_tail, 1u, __ATOMIC_RELAXED, __HIP_MEMORY_SCOPE_AGENT);
    }
    __device__ __forceinline__ void fused(f32x4 (&acc)[2][2][4][2], const Unit& u, int wr, int wc, int fr, int fq, PG8_LAS unsigned char* lds, int wid, int lane) const {
        PG8_LAS float* P = (PG8_LAS float*)lds;
        PG8_LAS float* S = (PG8_LAS float*)(lds + 4096);
        const int row0 = u.pm * BM + wr * 64 + fr, col0 = u.pn * BM + wc * 32 + 4 * fq;
        f32x4 rg[2][2], gq[2][2];
#pragma unroll
        for (int bj = 0; bj < 2; ++bj)
#pragma unroll
            for (int n = 0; n < 2; ++n) { const f32x4 g = *(const f32x4*)(gf + col0 + bj * HALF + n * 16); rg[bj][n] = (f32x4){__builtin_amdgcn_rcpf(g[0]), __builtin_amdgcn_rcpf(g[1]), __builtin_amdgcn_rcpf(g[2]), __builtin_amdgcn_rcpf(g[3])};
                gq[bj][n] = *(const f32x4*)(gfin + col0 + bj * HALF + n * 16); }
#pragma unroll
        for (int ai = 0; ai < 2; ++ai) {
            u32x2 hv[4][2][2];
#pragma unroll
            for (int m = 0; m < 4; ++m) { const bf16_t* ap = a2 + (size_t)(row0 + ai * HALF + m * 16) * 1024 + col0;
#pragma unroll
                for (int bj = 0; bj < 2; ++bj)
#pragma unroll
                    for (int n = 0; n < 2; ++n) hv[m][bj][n] = *(const u32x2*)(ap + bj * HALF + n * 16); }
#pragma unroll
            for (int m = 0; m < 4; ++m) { float ss = 0.f;
#pragma unroll
                for (int bj = 0; bj < 2; ++bj)
#pragma unroll
                    for (int n = 0; n < 2; ++n) { const u32x2 w = hv[m][bj][n];
                        const f32x4 h2 = (f32x4){__builtin_bit_cast(float, w.x << 16), __builtin_bit_cast(float, w.x & 0xffff0000u), __builtin_bit_cast(float, w.y << 16), __builtin_bit_cast(float, w.y & 0xffff0000u)} * rg[bj][n];
                        const f32x4 h3 = h2 + acc[ai][bj][m][n]; acc[ai][bj][m][n] = h3; ss += (h3[0] * h3[0] + h3[1] * h3[1]) + (h3[2] * h3[2] + h3[3] * h3[3]); }
                ss += __shfl_xor(ss, 16); ss += __shfl_xor(ss, 32);
                if (fq == 0) P[(ai * HALF + wr * 64 + m * 16 + fr) * 4 + wc] = ss; }
            asm volatile("" ::: "memory"); }
        asm volatile("s_waitcnt lgkmcnt(0)" ::: "memory"); __builtin_amdgcn_s_barrier(); asm volatile("" ::: "memory");
        const int row = wid * 32 + (lane & 31);
        if (lane < 32) { const f32x4 p4 = *(const PG8_LAS f32x4*)(P + row * 4);
            __hip_atomic_store(xch + ((size_t)(u.pm * BM + row) * 4 + u.pn), (p4[0] + p4[1]) + (p4[2] + p4[3]), __ATOMIC_RELAXED, __HIP_MEMORY_SCOPE_AGENT); }
        asm volatile("s_waitcnt vmcnt(0)" ::: "memory");
        if (lane == 0) __hip_atomic_fetch_add(cnt + 16 * u.pm, 1u, __ATOMIC_RELAXED, __HIP_MEMORY_SCOPE_AGENT);
        if (wid == 0) { unsigned polls = 0;
            while ((unsigned)__builtin_amdgcn_readfirstlane(__hip_atomic_load(cnt + 16 * u.pm, __ATOMIC_RELAXED, __HIP_MEMORY_SCOPE_AGENT)) < 32u) { __builtin_amdgcn_s_sleep(2); if (++polls > (1u << 22)) break; }
            __builtin_amdgcn_fence(__ATOMIC_ACQUIRE, "agent"); }
        asm volatile("s_waitcnt vmcnt(0) lgkmcnt(0)" ::: "memory"); __builtin_amdgcn_s_barrier(); asm volatile("" ::: "memory");
        if (lane < 32) { const float* xp4 = xch + (size_t)(u.pm * BM + row) * 4; float t = 0.f;
#pragma unroll
            for (int q = 0; q < 4; ++q) t += __hip_atomic_load(xp4 + q, __ATOMIC_RELAXED, __HIP_MEMORY_SCOPE_AGENT);
            S[row] = 1.0f / sqrtf(t * (1.0f / 1024.0f) + 1e-6f); }
        asm volatile("s_waitcnt lgkmcnt(0)" ::: "memory"); __builtin_amdgcn_s_barrier(); asm volatile("" ::: "memory");
#pragma unroll
        for (int ai = 0; ai < 2; ++ai)
#pragma unroll
            for (int m = 0; m < 4; ++m) { const int r = ai * HALF + wr * 64 + m * 16 + fr; const float sr = S[r]; float* op = out + (size_t)(u.pm * BM + r) * 1024 + col0;
#pragma unroll
                for (int bj = 0; bj < 2; ++bj)
#pragma unroll
                    for (int n = 0; n < 2; ++n) *(f32x4*)(op + bj * HALF + n * 16) = acc[ai][bj][m][n] * sr * gq[bj][n]; }
    }
};
template <class Epi, class Sched, bool ALIGN_EPI = false, bool SP2 = false>
__device__ __forceinline__ void gemm_phase(PG8_LAS unsigned char* lds, const Gemm g, const Sched& S, const Epi& E) {
    const int tid = threadIdx.x, wid = __builtin_amdgcn_readfirstlane(tid >> 6), lane = tid & 63, wr = wid >> 2, wc = wid & 3, fr = lane & 15, fq = lane >> 4;
    const int K = g.K;
    unsigned voffA[2], voffB[2];
#pragma unroll
    for (int i = 0; i < 2; ++i) { int R, C; stage_rc(tid * 16 + i * 8192, R, C); const int Rb = Epi::PERM ? ((R & ~31) + perm32(R & 31)) : R;
        voffA[i] = (unsigned)(R * K + C) * 2u; voffB[i] = (unsigned)(Rb * K + C) * 2u; }
    const size_t kstep = (size_t)(BK * 2);
    const size_t hstep = (size_t)HALF * K * 2;
    const size_t tstep = 2 * hstep;
    const unsigned ldsw = (unsigned)wid * 1024u;
    const int aoff = lds_byte(wr * 64 + fr, fq * 8), boff = lds_byte(wc * 32 + fr, fq * 8);
#define PG8_SA(b, h) (((b) * 2 + (h)) * HTB)
#define PG8_SB(b, h) ((4 + (b) * 2 + (h)) * HTB)
#define PG8_STAGE(bufoff, gbase, voff) do { _Pragma("unroll") for (int _i = 0; _i < 2; ++_i) \
        __builtin_amdgcn_global_load_lds((const unsigned*)((const char*)(gbase) + (voff)[_i]), (PG8_LAS unsigned*)(lds + (bufoff) + ldsw + _i * 8192), 16, 0, 0); } while (0)
#define PG8_LDA(dst, b, h) do { _Pragma("unroll") for (int m = 0; m < 4; ++m) _Pragma("unroll") for (int k = 0; k < 2; ++k) dst[m][k] = *(const PG8_LAS bf16x8*)(lds + PG8_SA(b, h) + aoff + m * 2048 + k * 1024); } while (0)
#define PG8_LDB(dst, b, h) do { _Pragma("unroll") for (int n = 0; n < 2; ++n) _Pragma("unroll") for (int k = 0; k < 2; ++k) dst[n][k] = *(const PG8_LAS bf16x8*)(lds + PG8_SB(b, h) + boff + n * 2048 + k * 1024); } while (0)
#define PG8_MMA(ai, bj, At, Bt) do { __builtin_amdgcn_s_setprio(1); _Pragma("unroll") for (int m = 0; m < 4; ++m) _Pragma("unroll") for (int n = 0; n < 2; ++n) _Pragma("unroll") for (int k = 0; k < 2; ++k) \
        acc[ai][bj][m][n] = __builtin_amdgcn_mfma_f32_16x16x32_bf16(Bt[n][k], At[m][k], acc[ai][bj][m][n], 0, 0, 0); __builtin_amdgcn_s_setprio(0); } while (0)
#define PG8_WAIT_V(n) asm volatile("s_waitcnt vmcnt(" #n ")" ::: "memory")
#define PG8_WAIT_L(n) asm volatile("s_waitcnt lgkmcnt(" #n ")" ::: "memory")
#define PG8_BAR __builtin_amdgcn_s_barrier()
#define PG8_SCHED __builtin_amdgcn_sched_barrier(0)
    Unit cur, nxt; int ui = 0;
    if (!S.next(0, cur)) return;
    f32x4 acc[2][2][4][2];
#pragma unroll
    for (int a = 0; a < 2; ++a)
#pragma unroll
        for (int b = 0; b < 2; ++b)
#pragma unroll
            for (int m = 0; m < 4; ++m)
#pragma unroll
                for (int n = 0; n < 2; ++n) acc[a][b][m][n] = (f32x4){0.f, 0.f, 0.f, 0.f};
    bf16x8 At[4][2], B0[2][2], B1[2][2];
    const char* cA = (const char*)g.A + (size_t)cur.pm * tstep + (size_t)cur.k0 * 2; const char* cB = (const char*)g.Bt + (size_t)cur.pn * tstep + (size_t)cur.k0 * 2;
    S.a_ready(cur);
    if constexpr (SP2) {
        PG8_STAGE(PG8_SB(0, 0), cB, voffB); PG8_STAGE(PG8_SB(0, 1), cB + hstep, voffB); PG8_STAGE(PG8_SA(0, 0), cA, voffA); PG8_STAGE(PG8_SA(0, 1), cA + hstep, voffA);
        if (wr == 1) PG8_BAR;
        PG8_WAIT_V(2); PG8_BAR;
        PG8_STAGE(PG8_SB(1, 0), cB + kstep, voffB); PG8_STAGE(PG8_SA(1, 0), cA + kstep, voffA); PG8_STAGE(PG8_SB(1, 1), cB + hstep + kstep, voffB);
        PG8_WAIT_V(6); PG8_BAR;
    } else {
        PG8_STAGE(PG8_SB(0, 0), cB, voffB); PG8_STAGE(PG8_SA(0, 0), cA, voffA); PG8_STAGE(PG8_SB(0, 1), cB + hstep, voffB); PG8_STAGE(PG8_SA(0, 1), cA + hstep, voffA);
        if (wr == 1) PG8_BAR;
        PG8_WAIT_V(4); PG8_BAR;
        PG8_STAGE(PG8_SB(1, 0), cB + kstep, voffB); PG8_STAGE(PG8_SA(1, 0), cA + kstep, voffA); PG8_STAGE(PG8_SB(1, 1), cB + hstep + kstep, voffB);
        PG8_WAIT_V(6); PG8_BAR;
    }
    for (;;) {
        const bool has_next = S.next(ui + 1, nxt);
        const char* nA = has_next ? (const char*)g.A + (size_t)nxt.pm * tstep + (size_t)nxt.k0 * 2 : cA; const char* nB = has_next ? (const char*)g.Bt + (size_t)nxt.pn * tstep + (size_t)nxt.k0 * 2 : cB;
        const int nt = cur.nt;
        for (int t = 0; t < nt; t += 2) {
            const bool last = (t == nt - 2);
            const char* a1 = cA + (size_t)(t + 1) * kstep;
            const char* a2 = last ? nA : cA + (size_t)(t + 2) * kstep; const char* b2 = last ? nB : cB + (size_t)(t + 2) * kstep;
            const char* a3 = a2 + kstep; const char* b3 = b2 + kstep;
            if (last && has_next) S.a_ready(nxt);
            if constexpr (SP2) {
            PG8_LDB(B0, 0, 0); PG8_LDB(B1, 0, 1); PG8_SCHED; PG8_LDA(At, 0, 0); PG8_STAGE(PG8_SA(1, 1), a1 + hstep, voffA);
            PG8_WAIT_V(8); PG8_WAIT_L(0); PG8_BAR; PG8_MMA(0, 0, At, B0); PG8_MMA(0, 1, At, B1); PG8_BAR; PG8_SCHED;
            PG8_LDA(At, 0, 1); PG8_STAGE(PG8_SB(0, 0), b2, voffB); PG8_STAGE(PG8_SB(0, 1), b2 + hstep, voffB); PG8_STAGE(PG8_SA(0, 0), a2, voffA);
            PG8_WAIT_V(8); PG8_WAIT_L(0); PG8_BAR; PG8_MMA(1, 0, At, B0); PG8_MMA(1, 1, At, B1); PG8_BAR; PG8_SCHED;
            PG8_LDB(B0, 1, 0); PG8_LDB(B1, 1, 1); PG8_SCHED; PG8_LDA(At, 1, 0); PG8_STAGE(PG8_SA(0, 1), a2 + hstep, voffA);
            PG8_WAIT_V(8); PG8_WAIT_L(0); PG8_BAR; PG8_MMA(0, 0, At, B0); PG8_MMA(0, 1, At, B1); PG8_BAR; PG8_SCHED;
            PG8_LDA(At, 1, 1); PG8_STAGE(PG8_SB(1, 0), b3, voffB); PG8_STAGE(PG8_SB(1, 1), b3 + hstep, voffB); PG8_STAGE(PG8_SA(1, 0), a3, voffA);
            PG8_WAIT_V(8); PG8_WAIT_L(0); PG8_BAR; PG8_MMA(1, 0, At, B0); PG8_MMA(1, 1, At, B1); PG8_BAR; PG8_SCHED;
            } else {
            PG8_LDB(B0, 0, 0); PG8_SCHED; PG8_LDA(At, 0, 0); PG8_STAGE(PG8_SA(1, 1), a1 + hstep, voffA);
            PG8_WAIT_L(8); PG8_BAR; PG8_WAIT_L(0); PG8_MMA(0, 0, At, B0); PG8_BAR; PG8_SCHED;
            PG8_LDB(B1, 0, 1); PG8_STAGE(PG8_SB(0, 0), b2, voffB);
            PG8_BAR; PG8_WAIT_L(0); PG8_MMA(0, 1, At, B1); PG8_BAR;
            PG8_LDA(At, 0, 1); PG8_STAGE(PG8_SA(0, 0), a2, voffA);
            PG8_BAR; PG8_WAIT_L(0); PG8_MMA(1, 0, At, B0); PG8_BAR; PG8_SCHED;
            PG8_STAGE(PG8_SB(0, 1), b2 + hstep, voffB);
            PG8_WAIT_V(6); PG8_BAR; PG8_MMA(1, 1, At, B1); PG8_BAR;
            PG8_LDB(B0, 1, 0); PG8_SCHED; PG8_LDA(At, 1, 0); PG8_STAGE(PG8_SA(0, 1), a2 + hstep, voffA);
            PG8_WAIT_L(8); PG8_BAR; PG8_WAIT_L(0); PG8_MMA(0, 0, At, B0); PG8_BAR; PG8_SCHED;
            PG8_LDB(B1, 1, 1); PG8_STAGE(PG8_SB(1, 0), b3, voffB);
            PG8_BAR; PG8_WAIT_L(0); PG8_MMA(0, 1, At, B1); PG8_BAR;
            PG8_LDA(At, 1, 1); PG8_STAGE(PG8_SA(1, 0), a3, voffA);
            PG8_BAR; PG8_WAIT_L(0); PG8_MMA(1, 0, At, B0); PG8_BAR; PG8_SCHED;
            PG8_STAGE(PG8_SB(1, 1), b3 + hstep, voffB);
            PG8_WAIT_V(6); PG8_BAR; PG8_MMA(1, 1, At, B1); PG8_BAR;
            }
        }
        if constexpr (ALIGN_EPI) { if (wr == 0) PG8_BAR; }
        if (!Epi::AFTER_DRAIN || has_next) { E(acc, cur, wr, wc, fr, fq); S.done(cur); }
        if (!has_next) break;
#pragma unroll
        for (int a = 0; a < 2; ++a)
#pragma unroll
            for (int b = 0; b < 2; ++b)
#pragma unroll
                for (int m = 0; m < 4; ++m)
#pragma unroll
                    for (int n = 0; n < 2; ++n) acc[a][b][m][n] = (f32x4){0.f, 0.f, 0.f, 0.f};
        cur = nxt; cA = nA; cB = nB; ++ui;
        if constexpr (ALIGN_EPI) { if (wr == 1) PG8_BAR; }
    }
    PG8_WAIT_V(0);
    if constexpr (!ALIGN_EPI) { if (wr == 0) PG8_BAR; }
    PG8_BAR;
    if constexpr (Epi::AFTER_DRAIN) { E.fused(acc, cur, wr, wc, fr, fq, lds, wid, lane); S.done(cur); }
#undef PG8_SA
#undef PG8_SB
#undef PG8_STAGE
#undef PG8_LDA
#undef PG8_LDB
#undef PG8_MMA
#undef PG8_WAIT_V
#undef PG8_WAIT_L
#undef PG8_BAR
#undef PG8_SCHED
}
}
#ifndef MK_N_LAUNCHES
#define MK_N_LAUNCHES 1
#endif
constexpr int N_LAUNCHES = MK_N_LAUNCHES;
constexpr int N_PHASES = 9;
#define LAS __attribute__((address_space(3)))
typedef unsigned short bf16;
typedef unsigned v4u __attribute__((ext_vector_type(4)));
typedef unsigned v2u __attribute__((ext_vector_type(2)));
typedef float f32x4 __attribute__((ext_vector_type(4)));
typedef short bf16x8 __attribute__((ext_vector_type(8)));
#define LDS_WAIT() asm volatile("s_waitcnt lgkmcnt(0)" ::: "memory")
#define MFMA16(a, b, c) __builtin_amdgcn_mfma_f32_16x16x32_bf16((a), (b), (c), 0, 0, 0)

constexpr int D = 1024, SEQ = 2048, NBATCH = 8, TP = 2112  , MP1 = NBATCH * TP  , M1 = 17408, M2 = 16896;
constexpr int NZ = 3584, INW = 3592, FF = 4096, NCHUNK = 33, NITEM = NBATCH * NCHUNK * 4  ;
constexpr float EPS = 1e-6f;
constexpr size_t OUT_YS = 16777216, OUT_CAP = 17301504, OUT_CQP = 17309696, OUT_SSP = 17346560, OUT_CAS = 17870848, OUT_CQS = 18001920, OUT_SSS = 18591744;
constexpr size_t MiB = 1u << 20;
constexpr size_t WS_RS0 = 0, WS_AB = 128 * 1024, WS_SSPART = 768 * 1024, WS_EG = 1920 * 1024;
constexpr size_t WS_WIN = 2 * MiB, WS_WOUT = 9 * MiB, WS_WUP = 11 * MiB, WS_WDN = 19 * MiB;
constexpr size_t WS_YMIX = 27 * MiB;
constexpr size_t WS_Z = 61 * MiB;
constexpr size_t WS_CH = 180 * MiB;
constexpr size_t WS_UF = 61 * MiB;
constexpr size_t WS_A2 = 193 * MiB;
constexpr size_t WS_END = 256 * MiB;
static_assert(WS_CH + (size_t)NITEM * 73728 <= WS_END && WS_Z + (size_t)M1 * NZ * 2 <= WS_CH && WS_YMIX + (size_t)M1 * D * 2 <= WS_Z && WS_UF + (size_t)M2 * FF * 2 <= WS_A2 && WS_A2 + (size_t)M2 * D * 2 <= WS_END, "ws map");
constexpr int CH_ITEM = 73728, OFF_NW = 0, OFF_QD = 16384, OFF_KDT = 32768, OFF_QK = 49152, OFF_U = 57344;
constexpr int LDS_BYTES = 147456 + 64;
constexpr int LDS_BAR_OFF = 147456;
constexpr size_t WS_RDY = 2000 * 1024;
constexpr size_t WS_PCNT = 2008 * 1024;
constexpr size_t WS_BAR = 1984 * 1024;
constexpr int NKS7 = 8;

__device__ __forceinline__ float bf2f(unsigned short b) { return __builtin_bit_cast(float, (unsigned)b << 16); }
__device__ __forceinline__ float bflo(unsigned w) { return __builtin_bit_cast(float, w << 16); }
__device__ __forceinline__ float bfhi(unsigned w) { return __builtin_bit_cast(float, w & 0xffff0000u); }
__device__ __forceinline__ unsigned pk2(float lo, float hi) { return pg8::cvt_pk_bf16(lo, hi); }
__device__ __forceinline__ bf16x8 pack8(const f32x4& a, const f32x4& b) { const v4u p = (v4u){pk2(a[0], a[1]), pk2(a[2], a[3]), pk2(b[0], b[1]), pk2(b[2], b[3])}; return __builtin_bit_cast(bf16x8, p); }
__device__ __forceinline__ float wave_sum(float v) {
#pragma unroll
    for (int o = 1; o < 64; o <<= 1) v += __shfl_xor(v, o);
    return v;
}
__device__ __forceinline__ float siluf(float x) { return x * __builtin_amdgcn_rcpf(1.0f + __expf(-x)); }
__device__ __forceinline__ float softplusf(float x) { return x > 20.f ? x : log1pf(__expf(x)); }

__device__ __forceinline__ void p0_transpose_item(const float* W, int ldw, int nblk, int K, bf16* WT, LAS float* scr, int item, int lane) {
    const int kb = item / nblk, nb = item % nblk, k0 = 64 * kb, n0 = 32 * nb;
#pragma unroll 8
    for (int i = 0; i < 32; ++i) { const int kk = 2 * i + (lane >> 5); scr[kk * 33 + (lane & 31)] = W[(size_t)(k0 + kk) * ldw + n0 + (lane & 31)]; }
    LDS_WAIT(); asm volatile("" ::: "memory");
    const int c = lane & 7;
#pragma unroll
    for (int j = 0; j < 4; ++j) { const int n = (lane >> 3) + 8 * j; const LAS float* s = scr + (8 * c) * 33 + n;
        v4u o; o.x = pk2(s[0 * 33], s[1 * 33]); o.y = pk2(s[2 * 33], s[3 * 33]); o.z = pk2(s[4 * 33], s[5 * 33]); o.w = pk2(s[6 * 33], s[7 * 33]);
        *(v4u*)(WT + (size_t)(n0 + n) * K + k0 + 8 * c) = o; }
    LDS_WAIT(); asm volatile("" ::: "memory");
}

struct Args { const float* in[18]; float* out; unsigned char* ws; int ph_lo, ph_hi, dry, pad; };

__device__ __forceinline__ void late_weights(const Args& a, LAS float* scr, int first, int last, int gwi, int ngw, int lane) {
    constexpr int I_OUT = 16 * 32, I_UP = 16 * 128;
    unsigned char* ws = a.ws;
    for (int it = first + gwi; it < last; it += ngw) {
        int r = it;
        if (r < I_OUT) { p0_transpose_item(a.in[13], 1024, 32, 1024, (bf16*)(ws + WS_WOUT), scr, r, lane); continue; } r -= I_OUT;
        if (r < I_UP) { p0_transpose_item(a.in[15], FF, 128, 1024, (bf16*)(ws + WS_WUP), scr, r, lane); continue; } r -= I_UP;
        p0_transpose_item(a.in[16], 1024, 32, FF, (bf16*)(ws + WS_WDN), scr, r, lane);
    }
}
__device__ __forceinline__ void p0_prologue(const Args& a, LAS unsigned char* lds, int gw, int NGW, int wave, int lane) {
    unsigned char* ws = a.ws;
    LAS float* scr = (LAS float*)(lds + wave * 16384);
    for (int it = gw; it < 16 * 112; it += NGW) p0_transpose_item(a.in[7], INW, 112, 1024, (bf16*)(ws + WS_WIN), scr, it, lane);
    const float* xp = a.in[0]; const float* xs = a.in[1]; const float* meta = a.in[5]; const float* gm = a.in[6]; const float* win = a.in[7];
    f32x4 g4[4];
#pragma unroll
    for (int j = 0; j < 4; ++j) g4[j] = *(const f32x4*)(gm + 256 * j + 4 * lane);
    f32x4 w8[4][4][2];
#pragma unroll
    for (int j = 0; j < 4; ++j)
#pragma unroll
        for (int e = 0; e < 4; ++e) { const float* wp = win + (size_t)(256 * j + 4 * lane + e) * INW + 3584; w8[j][e][0] = *(const f32x4*)wp; w8[j][e][1] = *(const f32x4*)(wp + 4); }
    bf16* A0 = (bf16*)(ws + WS_YMIX); float* RS0 = (float*)(ws + WS_RS0); float* AB = (float*)(ws + WS_AB);
    auto row_src = [&](int r) -> const float* {
        if (r >= M1) return nullptr;
        if (r < MP1) { const int b = r / TP, p = r - b * TP; if (p >= 64) return xp + ((size_t)b * SEQ + (p - 64)) * D; if (p >= 48) return meta + (size_t)(p - 48) * D; return nullptr; }
        return xs + (size_t)(r - MP1) * D; };
    auto row_finish = [&](int r, const float* src, const f32x4 (&v)[4]) {
        if (r >= M1) return;
        v2u* orow = (v2u*)(A0 + (size_t)r * D) + lane;
        if (!src) {
#pragma unroll
            for (int j = 0; j < 4; ++j) orow[64 * j] = (v2u){0u, 0u};
            if (lane == 0) RS0[r] = 0.f;
            if (lane < 8) AB[(size_t)r * 8 + lane] = 0.f;
            return;
        }
        float ss = 0.f;
#pragma unroll
        for (int j = 0; j < 4; ++j) ss += (v[j][0] * v[j][0] + v[j][1] * v[j][1]) + (v[j][2] * v[j][2] + v[j][3] * v[j][3]);
        const float rinv = 1.0f / sqrtf(wave_sum(ss) * (1.0f / D) + EPS);
        f32x4 ab0 = {0.f, 0.f, 0.f, 0.f}, ab1 = {0.f, 0.f, 0.f, 0.f};
#pragma unroll
        for (int j = 0; j < 4; ++j) { const f32x4 gx = v[j] * g4[j]; orow[64 * j] = (v2u){pk2(gx[0], gx[1]), pk2(gx[2], gx[3])};
#pragma unroll
            for (int e = 0; e < 4; ++e) { ab0 += w8[j][e][0] * gx[e]; ab1 += w8[j][e][1] * gx[e]; } }
        float abv[8];
#pragma unroll
        for (int c = 0; c < 4; ++c) { abv[c] = wave_sum(ab0[c]) * rinv; abv[4 + c] = wave_sum(ab1[c]) * rinv; }
        if (lane == 0) { RS0[r] = rinv; *(f32x4*)(AB + (size_t)r * 8) = (f32x4){abv[0], abv[1], abv[2], abv[3]}; *(f32x4*)(AB + (size_t)r * 8 + 4) = (f32x4){abv[4], abv[5], abv[6], abv[7]}; } };
    for (int r = gw; r < M1; r += 2 * NGW) {
        const float* sA = row_src(r); const float* sB = row_src(r + NGW);
        f32x4 vA[4], vB[4];
#pragma unroll
        for (int j = 0; j < 4; ++j) { vA[j] = sA ? *((const f32x4*)sA + 64 * j + lane) : (f32x4){0.f, 0.f, 0.f, 0.f}; vB[j] = sB ? *((const f32x4*)sB + 64 * j + lane) : (f32x4){0.f, 0.f, 0.f, 0.f}; }
        row_finish(r, sA, vA); row_finish(r + NGW, sB, vB);
    }
}
#define GAS __attribute__((address_space(1)))
#define XB_TMO      128
#define XB_XCNT(j)  (256  + 64 * (j))
#define XB_XSUB(j)  (1280 + 64 * (j))
#define XB_XGEN(j)  (2304 + 64 * (j))
#define XB_TOP      3328
#define XB_TOPGEN   3392
#define XCD_BAR_WORDS 3456
#define XB_SPIN_CAP (1u << 18)

__device__ __forceinline__ unsigned xb_ld(unsigned* p)              { return __hip_atomic_load(p, __ATOMIC_RELAXED, __HIP_MEMORY_SCOPE_AGENT); }
__device__ __forceinline__ unsigned xb_add(unsigned* p, unsigned v) { return __hip_atomic_fetch_add(p, v, __ATOMIC_RELAXED, __HIP_MEMORY_SCOPE_AGENT); }
__device__ __forceinline__ unsigned xb_xcc_id() { return (unsigned)__builtin_amdgcn_s_getreg((3 << 11) | 20) & 0xFu; }
#define XB_SPIN(cond, bar) do { unsigned _sp = 0; while (cond) { __builtin_amdgcn_s_sleep(1); \
    if ((++_sp & 255u) == 0u) { if (xb_ld(&(bar)[XB_TMO])) break; if (_sp > XB_SPIN_CAP) { atomicAdd(&(bar)[XB_TMO], 1u); break; } } } } while (0)

struct XcdBarrier {
    unsigned* bar; unsigned x;
    volatile LAS unsigned* st;
};

__device__ __forceinline__ XcdBarrier xcd_barrier_post(unsigned* bar, volatile LAS unsigned* st) {
    XcdBarrier b; b.bar = bar; b.x = xb_xcc_id(); b.st = st;
    if (threadIdx.x == 0) (void)xb_add(&bar[XB_XCNT(b.x)], 1u);
    return b;
}
__device__ __forceinline__ void xcd_barrier_complete(unsigned* bar, unsigned x, unsigned& nloc, unsigned& nx) {
    const unsigned G = gridDim.x * gridDim.y * gridDim.z;
    unsigned sum, cnt, mine, sp = 0u;
    for (;;) {
        sum = 0u; cnt = 0u; mine = 0u;
#pragma unroll
        for (unsigned j = 0; j < 16; ++j) { const unsigned c = xb_ld(&bar[XB_XCNT(j)]); sum += c; cnt += (c > 0u) ? 1u : 0u; mine = (j == x) ? c : mine; }
        if (sum == G) break;
        __builtin_amdgcn_s_sleep(1);
        if ((++sp & 255u) == 0u) { if (xb_ld(&bar[XB_TMO])) break; if (sp > XB_SPIN_CAP) { atomicAdd(&bar[XB_TMO], 1u); break; } }
    }
    nloc = mine > 0u ? mine : 1u; nx = cnt > 0u ? cnt : 1u;
}

__device__ __forceinline__ void xcd_barrier(const XcdBarrier& b) {
    asm volatile("s_waitcnt vmcnt(0)" ::: "memory");
    __syncthreads();
    if (threadIdx.x == 0) {
        unsigned* bar = b.bar;
        __builtin_amdgcn_s_waitcnt(0);
        unsigned nloc = b.st[0], nx = b.st[1];
        if (nloc == 0u) { xcd_barrier_complete(bar, b.x, nloc, nx); b.st[0] = nloc; b.st[1] = nx; }
        const unsigned old = xb_add(&bar[XB_XSUB(b.x)], 1u);
        const unsigned gen = old / nloc;
        if (old + 1u == (gen + 1u) * nloc) {
            __builtin_amdgcn_fence(__ATOMIC_RELEASE, "agent");
            asm volatile("s_waitcnt vmcnt(0)" ::: "memory");
            const unsigned og = xb_add(&bar[XB_TOP], 1u);
            const unsigned tg = og / nx;
            if (og + 1u == (tg + 1u) * nx) xb_add(&bar[XB_TOPGEN], 1u);
            else XB_SPIN(xb_ld(&bar[XB_TOPGEN]) == tg, bar);
            __builtin_amdgcn_fence(__ATOMIC_ACQUIRE, "agent");
            xb_add(&bar[XB_XGEN(b.x)], 1u);
            asm volatile("s_waitcnt vmcnt(0)" ::: "memory");
        } else {
            XB_SPIN(xb_ld(&bar[XB_XGEN(b.x)]) == gen, bar);
            __builtin_amdgcn_fence(__ATOMIC_ACQUIRE, "agent");
            asm volatile("s_waitcnt vmcnt(0)" ::: "memory");
        }
    }
    __syncthreads();
}

constexpr int TCW = 32, TNQ = TCW / 4;
__host__ __device__ constexpr int tinv_count(int i) { int n = 0; for (int r = 1; r < i; ++r) n += (r + TCW - 1) / TCW; return n; }
template <int I, int HH, int NR> __device__ __forceinline__ void tinv_chunk(float (&x)[NR], f32x4 (&lbuf)[2][TNQ], const LAS float* LM, float& acc) {
    if constexpr (TCW * HH < I) {
        constexpr int par = (tinv_count(I) + HH) & 1;
        constexpr bool lasth = !(TCW * (HH + 1) < I);
        constexpr int ni = lasth ? I + 1 : I, nh = lasth ? 0 : HH + 1;
        if constexpr (ni < NR) {
#pragma unroll
            for (int q = 0; q < TNQ; ++q) { if (TCW * nh + 4 * q < ni) lbuf[par ^ 1][q] = *(const LAS f32x4*)(LM + ni * 64 + TCW * nh + 4 * q); }
        }
        asm volatile("" ::: "memory");
#pragma unroll
        for (int q = 0; q < TNQ; ++q) { const int m4 = TCW * HH + 4 * q; if (m4 < I) { const f32x4 l = lbuf[par][q];
            acc -= l[0] * x[m4]; if (m4 + 1 < I) acc -= l[1] * x[m4 + 1]; if (m4 + 2 < I) acc -= l[2] * x[m4 + 2]; if (m4 + 3 < I) acc -= l[3] * x[m4 + 3]; } }
        tinv_chunk<I, HH + 1, NR>(x, lbuf, LM, acc);
    }
}
template <int I, int NR> __device__ __forceinline__ void tinv_rows(float (&x)[NR], f32x4 (&lbuf)[2][TNQ], const LAS float* LM) {
    if constexpr (I < NR) { float acc = x[I]; tinv_chunk<I, 0, NR>(x, lbuf, LM, acc); x[I] = acc; tinv_rows<I + 1, NR>(x, lbuf, LM); }
}
__device__ __forceinline__ void p2_ya_item(int idx, const bf16* Z, const float* st_a, const float* cwa, bf16* YMIX) {
    const int r2 = idx >> 6, cgp = idx & 63, c0 = 8 * cgp;
    float ch[3][8];
    int r1;
    if (r2 < 16384) { const int b = r2 >> 11, t = r2 & 2047; r1 = b * TP + 64 + t;
#pragma unroll
        for (int j = 0; j < 3; ++j) { const v4u zc = *(const v4u*)(Z + (size_t)(r1 - 2 + j) * NZ + 512 + c0), zh = *(const v4u*)(Z + (size_t)(r1 - 2 + j) * NZ + 1024 + c0);
            ch[j][0] = bflo(zc.x) * bflo(zh.x); ch[j][1] = bfhi(zc.x) * bfhi(zh.x); ch[j][2] = bflo(zc.y) * bflo(zh.y); ch[j][3] = bfhi(zc.y) * bfhi(zh.y);
            ch[j][4] = bflo(zc.z) * bflo(zh.z); ch[j][5] = bfhi(zc.z) * bfhi(zh.z); ch[j][6] = bflo(zc.w) * bflo(zh.w); ch[j][7] = bfhi(zc.w) * bfhi(zh.w); }
    } else { const int sidx = r2 - 16384, s = sidx >> 2, t = sidx & 3; r1 = MP1 + sidx;
#pragma unroll
        for (int j = 0; j < 3; ++j) { const int pos = t - 2 + j;
            if (pos < 0) { const f32x4 s0 = *(const f32x4*)(st_a + (size_t)(s * 2 + pos + 2) * 512 + c0), s1 = *(const f32x4*)(st_a + (size_t)(s * 2 + pos + 2) * 512 + c0 + 4);
                ch[j][0] = s0[0]; ch[j][1] = s0[1]; ch[j][2] = s0[2]; ch[j][3] = s0[3]; ch[j][4] = s1[0]; ch[j][5] = s1[1]; ch[j][6] = s1[2]; ch[j][7] = s1[3]; }
            else { const size_t rr = (size_t)(MP1 + s * 4 + pos); const v4u zc = *(const v4u*)(Z + rr * NZ + 512 + c0), zh = *(const v4u*)(Z + rr * NZ + 1024 + c0);
                ch[j][0] = bflo(zc.x) * bflo(zh.x); ch[j][1] = bfhi(zc.x) * bfhi(zh.x); ch[j][2] = bflo(zc.y) * bflo(zh.y); ch[j][3] = bfhi(zc.y) * bfhi(zh.y);
                ch[j][4] = bflo(zc.z) * bflo(zh.z); ch[j][5] = bfhi(zc.z) * bfhi(zh.z); ch[j][6] = bflo(zc.w) * bflo(zh.w); ch[j][7] = bfhi(zc.w) * bfhi(zh.w); } }
    }
    float y[8];
#pragma unroll
    for (int e = 0; e < 8; ++e) y[e] = 0.f;
#pragma unroll
    for (int j = 0; j < 3; ++j) { const f32x4 w0 = *(const f32x4*)(cwa + j * 512 + c0), w1 = *(const f32x4*)(cwa + j * 512 + c0 + 4);
        y[0] += w0[0] * ch[j][0]; y[1] += w0[1] * ch[j][1]; y[2] += w0[2] * ch[j][2]; y[3] += w0[3] * ch[j][3]; y[4] += w1[0] * ch[j][4]; y[5] += w1[1] * ch[j][5]; y[6] += w1[2] * ch[j][6]; y[7] += w1[3] * ch[j][7]; }
    const v4u zb = *(const v4u*)(Z + (size_t)r1 * NZ + c0);
    *(v4u*)(YMIX + (size_t)r2 * D + c0) = (v4u){pk2(y[0] * bflo(zb.x), y[1] * bfhi(zb.x)), pk2(y[2] * bflo(zb.y), y[3] * bfhi(zb.y)), pk2(y[4] * bflo(zb.z), y[5] * bfhi(zb.z)), pk2(y[6] * bflo(zb.w), y[7] * bfhi(zb.w))};
}
__device__ __forceinline__ void p2_state_item(int e, const bf16* Z, float* out) {
    int seq, k, rowbase; size_t oa, oq;
    if (e < NBATCH * 5632) { seq = e / 5632; k = e - seq * 5632; rowbase = seq * TP + 2112; oa = OUT_CAP; oq = OUT_CQP; }
    else { const int e2 = e - NBATCH * 5632; seq = e2 / 5632; k = e2 - seq * 5632; rowbase = MP1 + seq * 4 + 4; oa = OUT_CAS; oq = OUT_CQS; }
    if (k < 1024) { const int j = k >> 9, c = k & 511; const size_t row = (size_t)(rowbase - 2 + j);
        out[oa + (size_t)seq * 1024 + k] = bf2f(Z[row * NZ + 512 + c]) * bf2f(Z[row * NZ + 1024 + c]); }
    else { const int k2 = k - 1024, j = k2 / 1536, c = k2 - j * 1536; const size_t row = (size_t)(rowbase - 3 + j);
        out[oq + (size_t)seq * 4608 + k2] = bf2f(Z[row * NZ + 1536 + c]); }
}

typedef unsigned long long u64g;
__device__ __forceinline__ void wt_store16(__amdgpu_buffer_rsrc_t rsrc, unsigned off, v4u v) { __builtin_amdgcn_raw_buffer_store_b128(v, rsrc, off, 0,   16); }
__device__ __forceinline__ void wt_store8(unsigned char* p, v2u v) { __hip_atomic_store((u64g*)p, (u64g)v.x | ((u64g)v.y << 32), __ATOMIC_RELAXED, __HIP_MEMORY_SCOPE_AGENT); }
__device__ __forceinline__ void p2_publish(unsigned* RDY, int item) {
    __hip_atomic_store(RDY + item, 1u, __ATOMIC_RELAXED, __HIP_MEMORY_SCOPE_AGENT);
}
__device__ __forceinline__ void p2_chunk_item(LAS unsigned char* lds, int item, const bf16* Z, const float* AB, const float* convw, const float* a_log, const float* dt_bias,
                                              unsigned char* CH, float* EG, unsigned* RDY, int prev_item, int lane, int wave) {
    const int h = item & 3, bc = item >> 2, c = bc % NCHUNK, b = bc / NCHUNK;
    const int rbase = b * TP + 64 * c;
    LAS float* LM = (LAS float*)(lds); LAS float* GA = (LAS float*)(lds + 16384); LAS float* GC = GA + 64; LAS float* BE = GA + 128;
    LAS bf16* QS = (LAS bf16*)(lds + 17408); LAS bf16* KS = (LAS bf16*)(lds + 34816); LAS bf16* KT = (LAS bf16*)(lds + 52224); LAS bf16* VT = (LAS bf16*)(lds + 70656); LAS bf16* TM = (LAS bf16*)(lds + 89088);
    unsigned char* chi = CH + (size_t)item * CH_ITEM;
    const __amdgpu_buffer_rsrc_t chr = __builtin_amdgcn_make_buffer_rsrc(CH, 0, NITEM * CH_ITEM, 0x00020000);
    const unsigned cho = (unsigned)item * (unsigned)CH_ITEM;
    {
        const int i0 = wave * 8;
        int lnA = lane; asm volatile("" : "+v"(lnA));
        if (lnA < 48) {
            const int part = lnA >> 4, cgp = lnA & 15, colq = part * 512 + h * 128 + 8 * cgp;
            f32x4 cw[4][2];
#pragma unroll
            for (int j = 0; j < 4; ++j) { cw[j][0] = *(const f32x4*)(convw + j * 1536 + colq); cw[j][1] = *(const f32x4*)(convw + j * 1536 + colq + 4); }
            v4u zr[11];
#pragma unroll
            for (int k = 0; k < 11; ++k) { const int p = 64 * c + i0 - 3 + k;
                zr[k] = (p >= 0) ? *(const v4u*)(Z + (size_t)(rbase + i0 - 3 + k) * NZ + 1536 + colq) : (v4u){0u, 0u, 0u, 0u}; }
#pragma unroll
            for (int hh = 0; hh < 2; ++hh) {
                const int ib = i0 + 4 * hh;
                float av[4][8];
#pragma unroll
                for (int i = 0; i < 4; ++i) {
#pragma unroll
                    for (int e = 0; e < 8; ++e) av[i][e] = 0.f;
#pragma unroll
                    for (int j = 0; j < 4; ++j) { const v4u z = zr[4 * hh + i + j];
                        av[i][0] += cw[j][0][0] * bflo(z.x); av[i][1] += cw[j][0][1] * bfhi(z.x); av[i][2] += cw[j][0][2] * bflo(z.y); av[i][3] += cw[j][0][3] * bfhi(z.y);
                        av[i][4] += cw[j][1][0] * bflo(z.z); av[i][5] += cw[j][1][1] * bfhi(z.z); av[i][6] += cw[j][1][2] * bflo(z.w); av[i][7] += cw[j][1][3] * bfhi(z.w); }
                    float ss = 0.f;
#pragma unroll
                    for (int e = 0; e < 8; ++e) { av[i][e] = siluf(av[i][e]); ss += av[i][e] * av[i][e]; }
                    ss += __shfl_xor(ss, 1); ss += __shfl_xor(ss, 2); ss += __shfl_xor(ss, 4); ss += __shfl_xor(ss, 8);
                    const float sc = (part == 2) ? 1.0f : __builtin_amdgcn_rsqf(ss + EPS) * (part == 0 ? 0.08838834764831845f : 1.0f);
#pragma unroll
                    for (int e = 0; e < 8; ++e) av[i][e] *= sc;
                }
                if (part < 2) { LAS bf16* R = (part == 0) ? QS : KS;
#pragma unroll
                    for (int i = 0; i < 4; ++i) *(LAS v4u*)(R + (ib + i) * 136 + 8 * cgp) = (v4u){pk2(av[i][0], av[i][1]), pk2(av[i][2], av[i][3]), pk2(av[i][4], av[i][5]), pk2(av[i][6], av[i][7])}; }
                if (part >= 1) { LAS bf16* T = (part == 1) ? KT : VT;
#pragma unroll
                    for (int e = 0; e < 8; ++e) *(LAS v2u*)(T + (8 * cgp + e) * 72 + ib) = (v2u){pk2(av[0][e], av[1][e]), pk2(av[2][e], av[3][e])}; }
            }
        } else if (lnA < 56) {
            const int i = i0 + (lnA - 48); const size_t row = (size_t)(rbase + i);
            const float al = AB[row * 8 + h], bz = AB[row * 8 + 4 + h];
            float g = -__expf(a_log[h]) * softplusf(al + dt_bias[h]);
            if (c == 0 && i < 48) g = 0.f;
            GA[i] = g; BE[i] = __builtin_amdgcn_rcpf(1.0f + __expf(-bz));
        }
    }
    asm volatile("s_waitcnt vmcnt(0)" ::: "memory");
    __syncthreads();
    if (wave == 0) { float g = GA[lane];
#pragma unroll
        for (int o = 1; o < 64; o <<= 1) { const float t = __shfl_up(g, o); if (lane >= o) g += t; }
        GC[lane] = g; }
    __syncthreads();
    {
        int lnB = lane; asm volatile("" : "+v"(lnB)); const int n16 = lnB & 15, g4 = lnB >> 4, lane = lnB;
        const int jt = wave & 3;
#pragma unroll
        for (int ii = 0; ii < 2; ++ii) { const int it = (wave >> 2) * 2 + ii;
            f32x4 kk = {0.f, 0.f, 0.f, 0.f}, qk = {0.f, 0.f, 0.f, 0.f};
            if (it >= jt) {
#pragma unroll
                for (int ks = 0; ks < 4; ++ks) { const bf16x8 A = *(const LAS bf16x8*)(KS + (16 * jt + n16) * 136 + 32 * ks + 8 * g4);
                    const bf16x8 Bk = *(const LAS bf16x8*)(KS + (16 * it + n16) * 136 + 32 * ks + 8 * g4), Bq = *(const LAS bf16x8*)(QS + (16 * it + n16) * 136 + 32 * ks + 8 * g4);
                    kk = MFMA16(A, Bk, kk); qk = MFMA16(A, Bq, qk); }
                const int i = 16 * it + n16; const float Gi = GC[i], bi = BE[i]; const f32x4 Gj = *(const LAS f32x4*)(GC + 16 * jt + 4 * g4);
#pragma unroll
                for (int r = 0; r < 4; ++r) { const int j = 16 * jt + 4 * g4 + r; const float d = __expf(fminf(Gi - Gj[r], 0.f));
                    kk[r] = (i > j) ? bi * kk[r] * d : 0.f; qk[r] = (i >= j) ? qk[r] * d : 0.f; }
                *(LAS f32x4*)(LM + i * 64 + 16 * jt + 4 * g4) = kk;
            }
            wt_store8(chi + OFF_QK + ((size_t)((it * 2 + (jt >> 1)) * 64 + lane) * 8 + (jt & 1) * 4) * 2, (v2u){pk2(qk[0], qk[1]), pk2(qk[2], qk[3])});
        }
    }
    __syncthreads();
    LAS bf16* T11c = (LAS bf16*)(lds + 98304); LAS bf16* Xc = (LAS bf16*)(lds + 100864);
    if (wave < 2) {
        const LAS float* Lb = LM + wave * (32 * 64 + 32);
        float x[32];
        int ln = lane; asm volatile("" : "+v"(ln));
#pragma unroll
        for (int i = 0; i < 32; ++i) x[i] = (i == ln) ? 1.f : 0.f;
        f32x4 lbuf[2][TNQ];
        lbuf[0][0] = *(const LAS f32x4*)(Lb + 64);
        tinv_rows<1, 32>(x, lbuf, Lb);
        if (wave == 0) {
#pragma unroll
            for (int i = 0; i < 32; i += 2) { const unsigned w = pk2(x[i], x[i + 1]); TM[i * 72 + ln] = (bf16)(w & 0xffffu); TM[(i + 1) * 72 + ln] = (bf16)(w >> 16); }
            if (ln < 32) {
#pragma unroll
                for (int i = 0; i < 32; i += 8) *(LAS v4u*)(T11c + ln * 40 + i) = (v4u){pk2(x[i], x[i + 1]), pk2(x[i + 2], x[i + 3]), pk2(x[i + 4], x[i + 5]), pk2(x[i + 6], x[i + 7])}; }
        } else if (ln < 32) {
#pragma unroll
            for (int i = 0; i < 32; i += 2) { const unsigned w = pk2(x[i], x[i + 1]); TM[(32 + i) * 72 + 32 + ln] = (bf16)(w & 0xffffu); TM[(33 + i) * 72 + 32 + ln] = (bf16)(w >> 16); }
        }
    } else {
        int lnC = lane; asm volatile("" : "+v"(lnC)); const int n16 = lnC & 15, g4 = lnC >> 4, lane = lnC;
        const float glast = GC[63];
        for (int q = wave - 2; q < 32; q += 6) {
            if (q < 16) { const int mt = q >> 2, kb = q & 3, i = 16 * mt + n16; const float e = __expf(GC[i]);
                const v2u lo = *(const LAS v2u*)(QS + i * 136 + 32 * kb + 4 * g4), hi = *(const LAS v2u*)(QS + i * 136 + 32 * kb + 16 + 4 * g4);
                wt_store16(chr, cho + OFF_QD + (unsigned)((mt * 4 + kb) * 64 + lane) * 16u, (v4u){pk2(bflo(lo.x) * e, bfhi(lo.x) * e), pk2(bflo(lo.y) * e, bfhi(lo.y) * e), pk2(bflo(hi.x) * e, bfhi(hi.x) * e), pk2(bflo(hi.y) * e, bfhi(hi.y) * e)});
            } else { const int q2 = q - 16, mt8 = q2 >> 1, tb = q2 & 1, dk = 16 * mt8 + n16, t0 = 32 * tb + 4 * g4;
                const v2u lo = *(const LAS v2u*)(KT + dk * 72 + t0), hi = *(const LAS v2u*)(KT + dk * 72 + t0 + 16);
                const f32x4 G0 = *(const LAS f32x4*)(GC + t0), G1 = *(const LAS f32x4*)(GC + t0 + 16);
                float f0[4], f1[4];
#pragma unroll
                for (int r = 0; r < 4; ++r) { f0[r] = __expf(glast - G0[r]); f1[r] = __expf(glast - G1[r]); }
                wt_store16(chr, cho + OFF_KDT + (unsigned)((mt8 * 2 + tb) * 64 + lane) * 16u, (v4u){pk2(bflo(lo.x) * f0[0], bfhi(lo.x) * f0[1]), pk2(bflo(lo.y) * f0[2], bfhi(lo.y) * f0[3]), pk2(bflo(hi.x) * f1[0], bfhi(hi.x) * f1[1]), pk2(bflo(hi.y) * f1[2], bfhi(hi.y) * f1[3])});
            }
        }
        if (wave == 2 && lane == 0) __hip_atomic_store(EG + item, __expf(glast), __ATOMIC_RELAXED, __HIP_MEMORY_SCOPE_AGENT);
        if (wave == 7 && lane == 0 && prev_item >= 0) p2_publish(RDY, prev_item);
    }
    __syncthreads();
    if (wave < 4) {
        int lnX = lane; asm volatile("" : "+v"(lnX)); const int n16 = lnX & 15, g4 = lnX >> 4, mt = wave >> 1, nt = wave & 1;
        const f32x4 l0 = *(const LAS f32x4*)(LM + (32 + 16 * mt + n16) * 64 + 8 * g4), l1 = *(const LAS f32x4*)(LM + (32 + 16 * mt + n16) * 64 + 8 * g4 + 4);
        const bf16x8 A = pack8(l0, l1), B = *(const LAS bf16x8*)(T11c + (16 * nt + n16) * 40 + 8 * g4);
        const f32x4 acc = MFMA16(A, B, ((f32x4){0.f, 0.f, 0.f, 0.f}));
        *(LAS v2u*)(Xc + (16 * nt + n16) * 40 + 16 * mt + 4 * g4) = (v2u){pk2(acc[0], acc[1]), pk2(acc[2], acc[3])};
    }
    __syncthreads();
    if (wave < 4) {
        int lnY = lane; asm volatile("" : "+v"(lnY)); const int n16 = lnY & 15, g4 = lnY >> 4, mt = wave >> 1, nt = wave & 1;
        const bf16x8 A = *(const LAS bf16x8*)(TM + (32 + 16 * mt + n16) * 72 + 32 + 8 * g4), B = *(const LAS bf16x8*)(Xc + (16 * nt + n16) * 40 + 8 * g4);
        const f32x4 acc = MFMA16(A, B, ((f32x4){0.f, 0.f, 0.f, 0.f}));
        const unsigned w0 = pk2(-acc[0], -acc[1]), w1 = pk2(-acc[2], -acc[3]);
        LAS bf16* tp = TM + (32 + 16 * mt + 4 * g4) * 72 + 16 * nt + n16;
        tp[0] = (bf16)(w0 & 0xffffu); tp[72] = (bf16)(w0 >> 16); tp[144] = (bf16)(w1 & 0xffffu); tp[216] = (bf16)(w1 >> 16);
    }
    __syncthreads();
    {
        int lnD = lane; asm volatile("" : "+v"(lnD)); const int n16 = lnD & 15, g4 = lnD >> 4, lane = lnD;
        bf16x8 Bv[2];
#pragma unroll
        for (int ks = 0; ks < 2; ++ks) { const v4u raw = *(const LAS v4u*)(VT + (16 * wave + n16) * 72 + 32 * ks + 8 * g4);
            const f32x4 b0 = *(const LAS f32x4*)(BE + 32 * ks + 8 * g4), b1 = *(const LAS f32x4*)(BE + 32 * ks + 8 * g4 + 4);
            const v4u pk = (v4u){pk2(bflo(raw.x) * b0[0], bfhi(raw.x) * b0[1]), pk2(bflo(raw.y) * b0[2], bfhi(raw.y) * b0[3]), pk2(bflo(raw.z) * b1[0], bfhi(raw.z) * b1[1]), pk2(bflo(raw.w) * b1[2], bfhi(raw.w) * b1[3])};
            Bv[ks] = __builtin_bit_cast(bf16x8, pk); }
#pragma unroll
        for (int mt = 0; mt < 4; ++mt) { f32x4 acc = {0.f, 0.f, 0.f, 0.f};
#pragma unroll
            for (int ks = 0; ks < 2; ++ks) { const bf16x8 A = *(const LAS bf16x8*)(TM + (16 * mt + n16) * 72 + 32 * ks + 8 * g4); acc = MFMA16(A, Bv[ks], acc); }
            wt_store8(chi + OFF_U + (size_t)((wave * 4 + mt) * 64 + lane) * 8, (v2u){pk2(acc[0], acc[1]), pk2(acc[2], acc[3])}); }
        const int kb = wave & 3;
        bf16x8 Aw[2][2];
#pragma unroll
        for (int dd = 0; dd < 2; ++dd)
#pragma unroll
            for (int ks = 0; ks < 2; ++ks) { const int t0 = 32 * ks + 8 * g4; const v4u raw = *(const LAS v4u*)(KT + (16 * (2 * kb + dd) + n16) * 72 + t0);
                const f32x4 b0 = *(const LAS f32x4*)(BE + t0), b1 = *(const LAS f32x4*)(BE + t0 + 4), G0 = *(const LAS f32x4*)(GC + t0), G1 = *(const LAS f32x4*)(GC + t0 + 4);
                float f[8];
#pragma unroll
                for (int r = 0; r < 4; ++r) { f[r] = b0[r] * __expf(G0[r]); f[4 + r] = b1[r] * __expf(G1[r]); }
                const v4u pk = (v4u){pk2(bflo(raw.x) * f[0], bfhi(raw.x) * f[1]), pk2(bflo(raw.y) * f[2], bfhi(raw.y) * f[3]), pk2(bflo(raw.z) * f[4], bfhi(raw.z) * f[5]), pk2(bflo(raw.w) * f[6], bfhi(raw.w) * f[7])};
                Aw[dd][ks] = __builtin_bit_cast(bf16x8, pk); }
#pragma unroll
        for (int ii = 0; ii < 2; ++ii) { const int it = (wave >> 2) * 2 + ii; f32x4 a0 = {0.f, 0.f, 0.f, 0.f}, a1 = {0.f, 0.f, 0.f, 0.f};
#pragma unroll
            for (int ks = 0; ks < 2; ++ks) { const bf16x8 Bt = *(const LAS bf16x8*)(TM + (16 * it + n16) * 72 + 32 * ks + 8 * g4); a0 = MFMA16(Aw[0][ks], Bt, a0); a1 = MFMA16(Aw[1][ks], Bt, a1); }
            wt_store16(chr, cho + OFF_NW + (unsigned)((it * 4 + kb) * 64 + lane) * 16u, (v4u){pk2(-a0[0], -a0[1]), pk2(-a0[2], -a0[3]), pk2(-a1[0], -a1[1]), pk2(-a1[2], -a1[3])}); }
    }
    __syncthreads();
}

__device__ __forceinline__ void p3_dma(LAS unsigned char* dst, const unsigned char* chi, int wave, int lane) {
#pragma unroll
    for (int j = 0; j < 9; ++j) { const int k = wave * 9 + j; __builtin_amdgcn_global_load_lds((const unsigned*)(chi + k * 1024 + lane * 16), (LAS unsigned*)(dst + k * 1024), 16, 0, 2);     }
}
__device__ __forceinline__ void p3_wait_item(unsigned* rdy) {
    unsigned sp = 0; while (__hip_atomic_load(rdy, __ATOMIC_RELAXED, __HIP_MEMORY_SCOPE_AGENT) == 0u) { __builtin_amdgcn_s_sleep(2); if (++sp > (1u << 22)) break; }
    __builtin_amdgcn_fence(__ATOMIC_ACQUIRE, "agent"); asm volatile("s_waitcnt vmcnt(0)" ::: "memory");
}
__device__ __forceinline__ void p3_chain_block(LAS unsigned char* lds, int bh, const unsigned char* CH, const float* EG, unsigned* RDY, float* O, float* ssm_out, int lane, int wave) {
    const int b = bh >> 2, h = bh & 3, n16 = lane & 15, g4 = lane >> 4;
    const int item0 = (b * NCHUNK) * 4 + h;
    f32x4 S[2][8];
#pragma unroll
    for (int q = 0; q < 2; ++q)
#pragma unroll
        for (int i = 0; i < 8; ++i) S[q][i] = (f32x4){0.f, 0.f, 0.f, 0.f};
    if (wave == 7 && lane == 0) { p3_wait_item(RDY + item0); p3_wait_item(RDY + item0 + 4); }
    __syncthreads();
    p3_dma(lds, CH + (size_t)item0 * CH_ITEM, wave, lane);
    asm volatile("s_waitcnt vmcnt(0)" ::: "memory");
    __syncthreads();
    for (int c = 0; c < NCHUNK; ++c) {
        if (c + 1 < NCHUNK) p3_dma(lds + ((c + 1) & 1) * CH_ITEM, CH + (size_t)(item0 + 4 * (c + 1)) * CH_ITEM, wave, lane);
        if (wave == 7 && lane == 0 && c + 2 < NCHUNK) p3_wait_item(RDY + item0 + 4 * (c + 2));
        if (wave < 4) {
            const LAS unsigned char* base = lds + (c & 1) * CH_ITEM + lane * 16;
            const float egl = EG[item0 + 4 * c];
            bf16x8 Sb[2][4];
#pragma unroll
            for (int q = 0; q < 2; ++q)
#pragma unroll
                for (int kb = 0; kb < 4; ++kb) Sb[q][kb] = pack8(S[q][2 * kb], S[q][2 * kb + 1]);
            f32x4 vn[2][4];
#pragma unroll
            for (int mt = 0; mt < 4; ++mt) {
#pragma unroll
                for (int q = 0; q < 2; ++q) { const v2u ur = *(const LAS v2u*)(lds + (c & 1) * CH_ITEM + OFF_U + (((2 * wave + q) * 4 + mt) * 64 + lane) * 8);
                    vn[q][mt] = (f32x4){bflo(ur.x), bfhi(ur.x), bflo(ur.y), bfhi(ur.y)}; }
#pragma unroll
                for (int kb = 0; kb < 4; ++kb) { const bf16x8 A = *(const LAS bf16x8*)(base + OFF_NW + (mt * 4 + kb) * 1024);
                    vn[0][mt] = MFMA16(A, Sb[0][kb], vn[0][mt]); vn[1][mt] = MFMA16(A, Sb[1][kb], vn[1][mt]); } }
            bf16x8 vb[2][2];
#pragma unroll
            for (int q = 0; q < 2; ++q) { vb[q][0] = pack8(vn[q][0], vn[q][1]); vb[q][1] = pack8(vn[q][2], vn[q][3]); }
            float* orow = O + (size_t)(b * TP + 64 * c + 4 * g4) * 512 + h * 128 + wave * 32 + n16;
#pragma unroll
            for (int mt = 0; mt < 4; ++mt) { f32x4 a0 = {0.f, 0.f, 0.f, 0.f}, a1 = {0.f, 0.f, 0.f, 0.f};
#pragma unroll
                for (int kb = 0; kb < 4; ++kb) { const bf16x8 A = *(const LAS bf16x8*)(base + OFF_QD + (mt * 4 + kb) * 1024); a0 = MFMA16(A, Sb[0][kb], a0); a1 = MFMA16(A, Sb[1][kb], a1); }
#pragma unroll
                for (int tb = 0; tb < 2; ++tb) { const bf16x8 A = *(const LAS bf16x8*)(base + OFF_QK + (mt * 2 + tb) * 1024); a0 = MFMA16(A, vb[0][tb], a0); a1 = MFMA16(A, vb[1][tb], a1); }
#pragma unroll
                for (int r = 0; r < 4; ++r) { orow[(size_t)(16 * mt + r) * 512] = a0[r]; orow[(size_t)(16 * mt + r) * 512 + 16] = a1[r]; } }
#pragma unroll
            for (int m8 = 0; m8 < 8; ++m8) { S[0][m8] = S[0][m8] * egl; S[1][m8] = S[1][m8] * egl;
#pragma unroll
                for (int tb = 0; tb < 2; ++tb) { const bf16x8 A = *(const LAS bf16x8*)(base + OFF_KDT + (m8 * 2 + tb) * 1024); S[0][m8] = MFMA16(A, vb[0][tb], S[0][m8]); S[1][m8] = MFMA16(A, vb[1][tb], S[1][m8]); } }
        }
        asm volatile("s_waitcnt vmcnt(0) lgkmcnt(0)" ::: "memory");
        __syncthreads();
    }
    if (wave < 4) {
        float* so = ssm_out + ((size_t)(b * 4 + h) * 128 + 4 * g4) * 128 + wave * 32 + n16;
#pragma unroll
        for (int m8 = 0; m8 < 8; ++m8)
#pragma unroll
            for (int r = 0; r < 4; ++r) { so[(size_t)(16 * m8 + r) * 128] = S[0][m8][r]; so[(size_t)(16 * m8 + r) * 128 + 16] = S[1][m8][r]; }
    }
}
__device__ __forceinline__ void p3_sample_item(LAS float* scr, int it, const bf16* Z, const float* AB, const float* st_qkv, const float* st_ssm, const float* convw,
                                               const float* a_log, const float* dt_bias, float* O, float* ssm_out, int lane) {
    const int half = it & 1, h = (it >> 1) & 3, s = it >> 3, r0 = MP1 + 4 * s;
    int chn[5] = {h * 128 + lane, h * 128 + 64 + lane, 512 + h * 128 + lane, 512 + h * 128 + 64 + lane, 1024 + h * 128 + half * 64 + lane};
    float val[4][5];
#pragma unroll
    for (int q = 0; q < 5; ++q) { float xp[7];
#pragma unroll
        for (int j = 0; j < 3; ++j) xp[j] = st_qkv[(size_t)(s * 3 + j) * 1536 + chn[q]];
#pragma unroll
        for (int t = 0; t < 4; ++t) xp[3 + t] = bf2f(Z[(size_t)(r0 + t) * NZ + 1536 + chn[q]]);
        float cw[4];
#pragma unroll
        for (int j = 0; j < 4; ++j) cw[j] = convw[j * 1536 + chn[q]];
#pragma unroll
        for (int t = 0; t < 4; ++t) { float a = 0.f;
#pragma unroll
            for (int j = 0; j < 4; ++j) a += cw[j] * xp[t + j];
            val[t][q] = siluf(a); } }
    float gt[4], bt[4];
#pragma unroll
    for (int t = 0; t < 4; ++t) {
        const float sq = 1.0f / sqrtf(wave_sum(val[t][0] * val[t][0] + val[t][1] * val[t][1]) + EPS) * 0.08838834764831845f;
        const float sk = 1.0f / sqrtf(wave_sum(val[t][2] * val[t][2] + val[t][3] * val[t][3]) + EPS);
        val[t][0] *= sq; val[t][1] *= sq; val[t][2] *= sk; val[t][3] *= sk;
        const float al = AB[(size_t)(r0 + t) * 8 + h], bz = AB[(size_t)(r0 + t) * 8 + 4 + h];
        gt[t] = __expf(-__expf(a_log[h]) * softplusf(al + dt_bias[h])); bt[t] = 1.0f / (1.0f + __expf(-bz)); }
    float S[128];
    const float* sp = st_ssm + (size_t)(s * 4 + h) * 16384 + half * 64 + lane;
#pragma unroll
    for (int d = 0; d < 128; ++d) S[d] = sp[(size_t)d * 128];
#pragma unroll
    for (int t = 0; t < 4; ++t) {
        scr[lane] = val[t][2]; scr[64 + lane] = val[t][3]; scr[128 + lane] = val[t][0]; scr[192 + lane] = val[t][1];
        LDS_WAIT();
        float ks = 0.f;
#pragma unroll
        for (int d = 0; d < 128; d += 4) { const f32x4 k4 = *(const volatile LAS f32x4*)(scr + d); ks += k4[0] * S[d]; ks += k4[1] * S[d + 1]; ks += k4[2] * S[d + 2]; ks += k4[3] * S[d + 3]; }
        const float a = gt[t], cc = bt[t] * (val[t][4] - a * ks);
        float o = 0.f;
#pragma unroll
        for (int d = 0; d < 128; d += 4) { const f32x4 k4 = *(const volatile LAS f32x4*)(scr + d), q4 = *(const volatile LAS f32x4*)(scr + 128 + d);
#pragma unroll
            for (int e = 0; e < 4; ++e) { S[d + e] = a * S[d + e] + k4[e] * cc; o += S[d + e] * q4[e]; } }
        O[(size_t)(r0 + t) * 512 + h * 128 + half * 64 + lane] = o;
        LDS_WAIT();
    }
    float* so = ssm_out + (size_t)(s * 4 + h) * 16384 + half * 64 + lane;
#pragma unroll
    for (int d = 0; d < 128; ++d) so[(size_t)d * 128] = S[d];
}
template <bool WT> __device__ __forceinline__ void p4_row_t(int r2, const float* O, const bf16* Z, const float* gn, bf16* YMIX, int lane) {
    const int r1 = (r2 < 16384) ? ((r2 >> 11) * TP + 64 + (r2 & 2047)) : (MP1 + (r2 - 16384));
    const int hd = lane >> 4, dv = (lane & 15) * 8;
    const f32x4 o0 = *(const f32x4*)(O + (size_t)r1 * 512 + hd * 128 + dv), o1 = *(const f32x4*)(O + (size_t)r1 * 512 + hd * 128 + dv + 4);
    float ss = (o0[0] * o0[0] + o0[1] * o0[1]) + (o0[2] * o0[2] + o0[3] * o0[3]) + (o1[0] * o1[0] + o1[1] * o1[1]) + (o1[2] * o1[2] + o1[3] * o1[3]);
    ss += __shfl_xor(ss, 1); ss += __shfl_xor(ss, 2); ss += __shfl_xor(ss, 4); ss += __shfl_xor(ss, 8);
    const float rinv = 1.0f / sqrtf(ss * (1.0f / 128.0f) + EPS);
    const f32x4 g0 = *(const f32x4*)(gn + dv), g1 = *(const f32x4*)(gn + dv + 4);
    const v4u zg = *(const v4u*)(Z + (size_t)r1 * NZ + 3072 + hd * 128 + dv);
    float y[8] = {o0[0] * g0[0] * siluf(bflo(zg.x)), o0[1] * g0[1] * siluf(bfhi(zg.x)), o0[2] * g0[2] * siluf(bflo(zg.y)), o0[3] * g0[3] * siluf(bfhi(zg.y)),
                  o1[0] * g1[0] * siluf(bflo(zg.z)), o1[1] * g1[1] * siluf(bfhi(zg.z)), o1[2] * g1[2] * siluf(bflo(zg.w)), o1[3] * g1[3] * siluf(bfhi(zg.w))};
    const v4u yv = (v4u){pk2(y[0] * rinv, y[1] * rinv), pk2(y[2] * rinv, y[3] * rinv), pk2(y[4] * rinv, y[5] * rinv), pk2(y[6] * rinv, y[7] * rinv)};
    if (WT) wt_store16(__builtin_amdgcn_make_buffer_rsrc(YMIX, 0, M2 * D * 2, 0x00020000), (unsigned)(((size_t)r2 * D + 512 + hd * 128 + dv) * 2), yv);
    else *(v4u*)(YMIX + (size_t)r2 * D + 512 + hd * 128 + dv) = yv;
}
__device__ __forceinline__ void p4_row(int r2, const float* O, const bf16* Z, const float* gn, bf16* YMIX, int lane) { p4_row_t<false>(r2, O, Z, gn, YMIX, lane); }

__global__ void __launch_bounds__(512, 2) hymba_fwd(Args args) {
    extern __shared__ __attribute__((aligned(16))) unsigned char lds_raw[];
    LAS unsigned char* lds = (LAS unsigned char*)lds_raw;
    const int tid = threadIdx.x, lane = tid & 63, wave = __builtin_amdgcn_readfirstlane(tid >> 6);
    const int G = gridDim.x, bx = blockIdx.x;
    const int gw = bx * 8 + wave, NGW = G * 8;
    unsigned char* ws = args.ws; float* out = args.out;
    const int lo = args.ph_lo, hi = args.ph_hi;
    bf16* Z = (bf16*)(ws + WS_Z); bf16* YMIX = (bf16*)(ws + WS_YMIX); float* AB = (float*)(ws + WS_AB); float* O = out;
#ifndef PHMASK
#define PHMASK 0x1ff
#endif
#define IN(k) (((PHMASK >> (k)) & 1) && lo <= (k) && (k) < hi)
    volatile LAS unsigned* bst = (volatile LAS unsigned*)(lds + LDS_BAR_OFF);
    XcdBarrier bar; bar.bar = (unsigned*)(ws + WS_BAR); bar.x = 0; bar.st = bst;
    if (hi - lo > 1) { if (tid < 2) bst[tid] = 0u; __syncthreads(); bar = xcd_barrier_post((unsigned*)(ws + WS_BAR), bst); }
    if (args.dry == 0x5a5a5a5a) cg::this_grid().sync();
#define SEAM(k) do { if (IN(k) && IN((k) + 1)) { xcd_barrier(bar); } } while (0)
    if (IN(0)) { p0_prologue(args, lds, gw, NGW, wave, lane); }
    SEAM(0);
    if (IN(1)) { pg8::Gemm g{(const pg8::bf16_t*)(ws + WS_YMIX), (const pg8::bf16_t*)(ws + WS_WIN), M1, NZ, D}; pg8::StaticOrder S; S.init(M1, NZ, G, bx, D);
        pg8::EpiZ E{(pg8::bf16_t*)Z, NZ, (const float*)(ws + WS_RS0)};
        pg8::gemm_phase<pg8::EpiZ, pg8::StaticOrder, true, true>(lds, g, S, E);
        if (bx >= 184) late_weights(args, (LAS float*)(lds + 8192 + wave * 16384), 0, 2560, (bx - 184) * 8 + wave, (G - 184) * 8, lane); }
    SEAM(1);
    if (IN(2)) {
        unsigned* RDY = (unsigned*)(ws + WS_RDY);
        if (bx < 32) { p3_chain_block(lds, bx, ws + WS_CH, (const float*)(ws + WS_EG), RDY, O, out + OUT_SSP, lane, wave); }
        else {
            int prev = -1;
            for (int sq = bx - 32; sq < NITEM; sq += G - 32) { const int c = sq >> 5, bh = sq & 31, it = ((bh >> 2) * NCHUNK + c) * 4 + (bh & 3);
                p2_chunk_item(lds, it, Z, AB, args.in[9], args.in[10], args.in[11], ws + WS_CH, (float*)(ws + WS_EG), RDY, prev, lane, wave); prev = it; }
            asm volatile("s_waitcnt vmcnt(0)" ::: "memory"); __syncthreads();
            if (tid == 0 && prev >= 0) p2_publish(RDY, prev);
            LAS float* scr = (LAS float*)(lds + wave * 1024);
            for (int it = (bx - 32) * 8 + wave; it < 1024; it += (G - 32) * 8) p3_sample_item(scr, it, Z, AB, args.in[3], args.in[4], args.in[9], args.in[10], args.in[11], O, out + OUT_SSS, lane);
            for (int idx = (bx - 32) * 512 + tid; idx < M2 * 64; idx += (G - 32) * 512) p2_ya_item(idx, Z, args.in[2], args.in[8], YMIX);
            for (int e = (bx - 32) * 512 + tid; e < (NBATCH + 128) * 5632; e += (G - 32) * 512) p2_state_item(e, Z, out);
        }
    }
    SEAM(2);
    if (IN(5)) { pg8::Gemm g{(const pg8::bf16_t*)YMIX, (const pg8::bf16_t*)(ws + WS_WOUT), M2, D, D}; pg8::StaticOrder S; S.init(16384, D, G, bx, D);
        { pg8::Unit u0; S.next(0, u0); unsigned* c5 = (unsigned*)(ws + WS_PCNT + 8192) + 16 * u0.pm; const int rb = u0.pm * 256 + u0.pn * 64 + wave * 8;
#pragma unroll
          for (int k4 = 0; k4 < 8; k4 += 4) {
#pragma unroll
              for (int k = 0; k < 4; ++k) p4_row_t<true>(rb + k4 + k, O, Z, args.in[12], YMIX, lane); }
          if (bx < 64) p4_row(16384 + bx * 8 + wave, O, Z, args.in[12], YMIX, lane);
          asm volatile("s_waitcnt vmcnt(0)" ::: "memory");
          if (lane == 0) __hip_atomic_fetch_add(c5, 1u, __ATOMIC_RELAXED, __HIP_MEMORY_SCOPE_AGENT);
          if (hi - lo > 1) { if (tid == 0) { unsigned sp = 0; while (__hip_atomic_load(c5, __ATOMIC_RELAXED, __HIP_MEMORY_SCOPE_AGENT) < 32u) { __builtin_amdgcn_s_sleep(2); if (++sp > (1u << 22)) break; }
                  __builtin_amdgcn_fence(__ATOMIC_ACQUIRE, "agent"); asm volatile("s_waitcnt vmcnt(0)" ::: "memory"); }
              __syncthreads(); } }
        pg8::EpiOut<false> E{args.in[0], args.in[1], out, (pg8::bf16_t*)(ws + WS_A2), args.in[14], (float*)(ws + WS_SSPART), (unsigned*)(ws + WS_PCNT)};
        pg8::gemm_phase<pg8::EpiOut<false>, pg8::StaticOrder, true, true>(lds, g, S, E); }
    SEAM(5);
    if (IN(6)) {
        if (bx < 8) {
            pg8::Gemm g5{(const pg8::bf16_t*)YMIX, (const pg8::bf16_t*)(ws + WS_WOUT), M2, D, D}; pg8::OneUnitOrder S5{64 + (bx >> 2), bx & 3, D / 64};
            pg8::EpiOut<true> E5{args.in[0], args.in[1], out, (pg8::bf16_t*)(ws + WS_A2), args.in[14], (float*)(ws + WS_SSPART), (unsigned*)(ws + WS_PCNT)};
            pg8::gemm_phase<pg8::EpiOut<true>, pg8::OneUnitOrder, true, true>(lds, g5, S5, E5); }
        pg8::Gemm g{(const pg8::bf16_t*)(ws + WS_A2), (const pg8::bf16_t*)(ws + WS_WUP), M2, FF, D}; pg8::SplitTailOrder S;
        S.init(16384, 512, FF, G, bx, D, 1, 8, (hi - lo > 1) ? (const unsigned*)(ws + WS_PCNT) : nullptr, 32u);
        pg8::EpiUp E{(pg8::bf16_t*)(ws + WS_UF), FF, (const float*)(ws + WS_SSPART)};
        pg8::gemm_phase<pg8::EpiUp, pg8::SplitTailOrder, true, true>(lds, g, S, E);
        if (bx >= 40) late_weights(args, (LAS float*)(lds + 8192 + wave * 16384), 2560, 4608, (bx - 40) * 8 + wave, (G - 40) * 8, lane); }
    SEAM(6);
    if (IN(7)) { pg8::Gemm g{(const pg8::bf16_t*)(ws + WS_UF), (const pg8::bf16_t*)(ws + WS_WDN), M2, D, FF}; pg8::SplitTailOrder S; S.init(16384, 512, D, G, bx, FF, NKS7); S.tail_first = 1;
        pg8::EpiDownNorm E{out, (float*)(ws + WS_YMIX), 16384, 512, (const pg8::bf16_t*)(ws + WS_A2), args.in[14], args.in[17], (float*)(ws + WS_SSPART), (unsigned*)(ws + WS_PCNT), (unsigned*)(ws + WS_PCNT + 12288)};
        pg8::gemm_phase<pg8::EpiDownNorm, pg8::SplitTailOrder, true, true>(lds, g, S, E);
        if (bx >= 64 && bx < 128) {
            if (hi - lo > 1) { if (tid == 0) { unsigned* c8 = (unsigned*)(ws + WS_PCNT + 12288); unsigned sp = 0; while (__hip_atomic_load(c8, __ATOMIC_RELAXED, __HIP_MEMORY_SCOPE_AGENT) < 512u) { __builtin_amdgcn_s_sleep(2); if (++sp > (1u << 22)) break; }
                    __builtin_amdgcn_fence(__ATOMIC_ACQUIRE, "agent"); asm volatile("s_waitcnt vmcnt(0)" ::: "memory"); }
                __syncthreads(); }
            const int r = 16384 + (bx - 64) * 8 + wave; const float* gfin = args.in[17]; f32x4 v[4]; float ss = 0.f;
#pragma unroll
            for (int j = 0; j < 4; ++j) { const v2u w = *((const v2u*)(ws + WS_A2 + (size_t)r * D * 2) + 64 * j + lane); const f32x4 gq = *(const f32x4*)(args.in[14] + 256 * j + 4 * lane);
                v[j] = (f32x4){bflo(w.x) * __builtin_amdgcn_rcpf(gq[0]), bfhi(w.x) * __builtin_amdgcn_rcpf(gq[1]), bflo(w.y) * __builtin_amdgcn_rcpf(gq[2]), bfhi(w.y) * __builtin_amdgcn_rcpf(gq[3])};
                const f32x4* pp = (const f32x4*)(ws + WS_YMIX) + (size_t)(r - 16384) * 256 + 64 * j + lane;
#pragma unroll
                for (int ks = 0; ks < NKS7; ++ks) v[j] += pp[(size_t)ks * 512 * 256];
                ss += (v[j][0] * v[j][0] + v[j][1] * v[j][1]) + (v[j][2] * v[j][2] + v[j][3] * v[j][3]); }
            const float rinv = 1.0f / sqrtf(wave_sum(ss) * (1.0f / D) + EPS); f32x4* rp = (f32x4*)(out + (size_t)r * D) + lane;
#pragma unroll
            for (int j = 0; j < 4; ++j) rp[64 * j] = v[j] * rinv * *(const f32x4*)(gfin + 256 * j + 4 * lane); } }
#undef IN
#undef SEAM
}

#ifndef REP_MASK
#define REP_MASK 0
#endif
extern "C" void kernel_launch(void* const* d_in, const int* in_sizes, int n_in, void* d_out, int out_size, void* d_ws, size_t ws_size, hipStream_t stream) {
    static int grid = 0;
    if (grid == 0) {
        if (n_in != 18 || ws_size < WS_END) { fprintf(stderr, "kernel_launch: unexpected n_in %d / ws %zu\n", n_in, ws_size); grid = -1; return; }
        int dev = 0, cus = 0, per_cu = 0;
        if (hipGetDevice(&dev) != hipSuccess || hipDeviceGetAttribute(&cus, hipDeviceAttributeMultiprocessorCount, dev) != hipSuccess) { grid = -1; return; }
        if (hipFuncSetAttribute((const void*)hymba_fwd, hipFuncAttributeMaxDynamicSharedMemorySize, LDS_BYTES) != hipSuccess) { fprintf(stderr, "kernel_launch: hipFuncSetAttribute failed\n"); grid = -1; return; }
        if (hipOccupancyMaxActiveBlocksPerMultiprocessor(&per_cu, (const void*)hymba_fwd, 512, LDS_BYTES) != hipSuccess || per_cu < 1) { fprintf(stderr, "kernel_launch: occupancy query gave %d\n", per_cu); (void)hipGetLastError(); per_cu = 1; }
        grid = cus * per_cu;
        if (grid > 256) grid = 256;
    }
    if (grid < 0) return;
    Args a{};
    for (int i = 0; i < 18; ++i) a.in[i] = (const float*)d_in[i];
    a.out = (float*)d_out; a.ws = (unsigned char*)d_ws;
    if (hipMemsetAsync((char*)d_ws + WS_BAR, 0, 40960, stream) != hipSuccess) { fprintf(stderr, "kernel_launch: memset of the barrier / flag words failed\n"); return; }
    if (N_LAUNCHES == 1) {
        a.ph_lo = 0; a.ph_hi = N_PHASES;
        void* kargs[] = {&a};
        hipError_t e = hipLaunchCooperativeKernel((const void*)hymba_fwd, dim3(grid), dim3(512), kargs, LDS_BYTES, stream);
        if (e != hipSuccess) fprintf(stderr, "cooperative launch failed: %s (grid %d)\n", hipGetErrorString(e), grid);
    } else {
        for (int p = 0; p < N_PHASES; ++p) { a.ph_lo = p; a.ph_hi = p + 1;
            for (int rep = 0; rep < ((REP_MASK >> p) & 1) + 1; ++rep) { a.dry = (p == 7 && rep + 1 < ((REP_MASK >> p) & 1) + 1) ? 1 : 0; hipLaunchKernelGGL(hymba_fwd, dim3(grid), dim3(512), LDS_BYTES, stream, a); } }
    }
}
```
